# Optimizing an MI355X kernel written in HIP

```python
import math
import jax
import jax.numpy as jnp
from jax import lax
import numpy as np

D_MODEL = 1024
BATCH = 4
SEQ = 4096
DEPTH = 4

CHUNK = 64
N_META = 16
Q_BLOCK = 128

A_HEADS = 4
A_DH = 64
A_DV = 2 * A_DH
A_QK = A_HEADS * 2 * A_DH
A_W = A_HEADS * A_DV
B_HEADS = 8
B_DH = 64
B_W = B_HEADS * B_DH
EVEN_W = A_W + B_W
EVEN_SPLITS = (A_QK, A_QK, A_W, A_W, B_W, B_W, B_W, B_W)
EVEN_IN = 2 * A_QK + 2 * A_W + 4 * B_W

C_HEADS = 8
C_NOPE = 128
C_ROPE = 64
C_DV = 128
C_QK = C_NOPE + C_ROPE
Q_LORA = 512
KV_LORA = 256
C_W = C_HEADS * C_DV
ODD_SPLITS = (Q_LORA, KV_LORA, C_ROPE, C_W)
ODD_IN = Q_LORA + KV_LORA + C_ROPE + C_W

ROPE_THETA = 10000.0
LN_EPS = 1e-5
RMS_EPS = 1e-6
ALPHA = (2.0 * DEPTH) ** 0.25
BETA = (8.0 * DEPTH) ** -0.25
N_EVEN = (DEPTH + 1) // 2
N_ODD = DEPTH // 2

kernel_name = "hybrid_diff_stickbreak_mla_streaming"


def layer_norm(x, g, b):
    xf = x.astype(jnp.float32)
    mu = jnp.mean(xf, axis=-1, keepdims=True)
    var = jnp.mean(jnp.square(xf - mu), axis=-1, keepdims=True)
    return ((xf - mu) * lax.rsqrt(var + LN_EPS) * g.astype(jnp.float32) + b.astype(jnp.float32)).astype(x.dtype)


def rms_norm(x, g):
    xf = x.astype(jnp.float32)
    return (xf * lax.rsqrt(jnp.mean(xf * xf, axis=-1, keepdims=True) + RMS_EPS) * g.astype(jnp.float32)).astype(x.dtype)


def chunk_id(pos):
    return jnp.where(pos < N_META, 0, 1 + (pos - N_META) // CHUNK)


def split_cols(h, sizes):
    idx = np.cumsum(sizes)[:-1].tolist()
    return jnp.split(h, idx, axis=-1)


def rope(x, pos):
    half = x.shape[-1] // 2
    inv_freq = ROPE_THETA ** (-jnp.arange(half, dtype=jnp.float32) / half)
    ang = pos.astype(jnp.float32)[:, None] * inv_freq[None, :]
    cos = jnp.cos(ang)[None, :, None, :]
    sin = jnp.sin(ang)[None, :, None, :]
    x1 = x[..., :half].astype(jnp.float32)
    x2 = x[..., half:].astype(jnp.float32)
    return jnp.concatenate([x1 * cos - x2 * sin, x2 * cos + x1 * sin], axis=-1).astype(x.dtype)


def sweep_query_blocks(fn, q):
    L = q.shape[1]
    n_blocks = L // Q_BLOCK

    def body(i):
        q0 = i * Q_BLOCK
        return fn(q0, lax.dynamic_slice_in_dim(q, q0, Q_BLOCK, axis=1))

    out = lax.map(body, jnp.arange(n_blocks))
    out = jnp.moveaxis(out, 0, 1)
    return out.reshape((out.shape[0], L) + out.shape[3:])


def even_layer(x, pos, cid, layer_idx, w_in, w_out, lam_q1, lam_k1, lam_q2, lam_k2, subln_g):
    bsz, L, _ = x.shape
    qa, ka, va, ga, qs, ks, vs, gs = split_cols(x @ w_in, EVEN_SPLITS)

    qa = qa.reshape(bsz, L, A_HEADS, 2, A_DH)
    ka = ka.reshape(bsz, L, A_HEADS, 2, A_DH)
    va = va.reshape(bsz, L, A_HEADS, A_DV)
    lam_init = 0.8 - 0.6 * math.exp(-0.3 * layer_idx)
    lam = (jnp.exp(jnp.sum(lam_q1.astype(jnp.float32) * lam_k1.astype(jnp.float32)))
           - jnp.exp(jnp.sum(lam_q2.astype(jnp.float32) * lam_k2.astype(jnp.float32)))
           + lam_init)
    slopes = jnp.asarray(2.0 ** (-8.0 * np.arange(1, A_HEADS + 1) / A_HEADS), dtype=jnp.float32)

    def diff_block(q0, qb):
        tq = q0 + jnp.arange(Q_BLOCK)
        s = jnp.einsum('bqhmd,bkhmd->bhmqk', qb, ka).astype(jnp.float32) * (A_DH ** -0.5)
        dist = jnp.abs(tq[:, None] - pos[None, :]).astype(jnp.float32)
        s = s - slopes[None, :, None, None, None] * dist
        visible = cid[None, :] <= chunk_id(tq)[:, None]
        p = jax.nn.softmax(jnp.where(visible, s, -jnp.inf), axis=-1)
        w = p[:, :, 0] - lam * p[:, :, 1]
        return jnp.einsum('bhqk,bkhd->bqhd', w.astype(va.dtype), va)

    oa = sweep_query_blocks(diff_block, qa)
    oa = rms_norm(oa, subln_g) * (1.0 - lam_init)
    ya = oa.reshape(bsz, L, A_W) * jax.nn.silu(ga)

    qs = qs.reshape(bsz, L, B_HEADS, B_DH)
    ks = ks.reshape(bsz, L, B_HEADS, B_DH)
    vs = vs.reshape(bsz, L, B_HEADS, B_DH)

    def sb_block(q0, qb):
        tq = q0 + jnp.arange(Q_BLOCK)
        z = jnp.einsum('bqhd,bkhd->bhqk', qb, ks).astype(jnp.float32) * (B_DH ** -0.5)
        earlier = pos[None, :] < tq[:, None]
        log_skip = jnp.where(earlier, jax.nn.log_sigmoid(-z), 0.0)
        log_pass = lax.cumsum(log_skip, axis=3, reverse=True) - log_skip
        a = jnp.where(earlier, jnp.exp(jax.nn.log_sigmoid(z) + log_pass), 0.0)
        return jnp.einsum('bhqk,bkhd->bqhd', a.astype(vs.dtype), vs)

    ys = sweep_query_blocks(sb_block, qs).reshape(bsz, L, B_W) * jax.nn.silu(gs)

    return jnp.concatenate([ya, ys], axis=-1) @ w_out


def odd_layer(x, pos, cid, w_in, q_norm, w_uq, kv_norm, w_ukv, w_out):
    bsz, L, _ = x.shape
    cq, ckv, k_pe, g = split_cols(x @ w_in, ODD_SPLITS)

    q = (rms_norm(cq, q_norm) @ w_uq).reshape(bsz, L, C_HEADS, C_QK)
    q = jnp.concatenate([q[..., :C_NOPE], rope(q[..., C_NOPE:], pos)], axis=-1)
    kv = (rms_norm(ckv, kv_norm) @ w_ukv).reshape(bsz, L, C_HEADS, C_NOPE + C_DV)
    k_pe = rope(k_pe[:, :, None, :], pos)
    k = jnp.concatenate([kv[..., :C_NOPE], jnp.broadcast_to(k_pe, (bsz, L, C_HEADS, C_ROPE))], axis=-1)
    v = kv[..., C_NOPE:]

    def mla_block(q0, qb):
        tq = q0 + jnp.arange(Q_BLOCK)
        s = jnp.einsum('bqhd,bkhd->bhqk', qb, k).astype(jnp.float32) * (C_QK ** -0.5)
        visible = cid[None, :] <= chunk_id(tq)[:, None]
        p = jax.nn.softmax(jnp.where(visible, s, -jnp.inf), axis=-1)
        return jnp.einsum('bhqk,bkhd->bqhd', p.astype(v.dtype), v)

    o = sweep_query_blocks(mla_block, q).reshape(bsz, L, C_W) * jax.nn.silu(g)
    return o @ w_out


def setup_inputs(seed: int = 0) -> dict:
    key = jax.random.key(seed)
    k = jax.random.split(key, 18)
    n = jax.random.normal
    f32 = jnp.float32
    return {
        "x": n(k[0], (BATCH, SEQ, D_MODEL), f32),
        "meta": n(k[1], (N_META, D_MODEL), f32),
        "ln_g": 1.0 + 0.02 * n(k[2], (DEPTH, D_MODEL), f32),
        "ln_b": 0.02 * n(k[3], (DEPTH, D_MODEL), f32),
        "ev_w_in": n(k[4], (N_EVEN, D_MODEL, EVEN_IN), f32) * D_MODEL ** -0.5,
        "ev_w_out": n(k[5], (N_EVEN, EVEN_W, D_MODEL), f32) * (EVEN_W ** -0.5 * BETA),
        "ev_lam_q1": 0.1 * n(k[6], (N_EVEN, A_DH), f32),
        "ev_lam_k1": 0.1 * n(k[7], (N_EVEN, A_DH), f32),
        "ev_lam_q2": 0.1 * n(k[8], (N_EVEN, A_DH), f32),
        "ev_lam_k2": 0.1 * n(k[9], (N_EVEN, A_DH), f32),
        "ev_subln": 1.0 + 0.02 * n(k[10], (N_EVEN, A_DV), f32),
        "od_w_in": n(k[11], (N_ODD, D_MODEL, ODD_IN), f32) * D_MODEL ** -0.5,
        "od_q_norm": 1.0 + 0.02 * n(k[12], (N_ODD, Q_LORA), f32),
        "od_w_uq": n(k[13], (N_ODD, Q_LORA, C_HEADS * C_QK), f32) * Q_LORA ** -0.5,
        "od_kv_norm": 1.0 + 0.02 * n(k[14], (N_ODD, KV_LORA), f32),
        "od_w_ukv": n(k[15], (N_ODD, KV_LORA, C_HEADS * (C_NOPE + C_DV)), f32) * KV_LORA ** -0.5,
        "od_w_out": n(k[16], (N_ODD, C_W, D_MODEL), f32) * (C_W ** -0.5 * BETA),
    }


def reference(x, meta, ln_g, ln_b, ev_w_in, ev_w_out, ev_lam_q1, ev_lam_k1, ev_lam_q2, ev_lam_k2,
              ev_subln, od_w_in, od_q_norm, od_w_uq, od_kv_norm, od_w_ukv, od_w_out):
    bsz, seq, d = x.shape
    L = N_META + seq
    L_pad = -(-L // Q_BLOCK) * Q_BLOCK
    h = jnp.concatenate([
        jnp.broadcast_to(meta.astype(x.dtype)[None], (bsz, N_META, d)),
        x,
        jnp.zeros((bsz, L_pad - L, d), x.dtype),
    ], axis=1)
    pos = jnp.arange(L_pad)
    cid = chunk_id(pos)

    for i in range(DEPTH):
        j = i // 2
        if i % 2 == 0:
            y = even_layer(h, pos, cid, i, ev_w_in[j], ev_w_out[j], ev_lam_q1[j], ev_lam_k1[j],
                           ev_lam_q2[j], ev_lam_k2[j], ev_subln[j])
        else:
            y = odd_layer(h, pos, cid, od_w_in[j], od_q_norm[j], od_w_uq[j], od_kv_norm[j],
                          od_w_ukv[j], od_w_out[j])
        h = layer_norm(ALPHA * h + y, ln_g[i], ln_b[i])

    return h[:, N_META:N_META + seq]
```

```cpp
#include <hip/hip_runtime.h>
#include <hip/hip_cooperative_groups.h>
#include <stdint.h>
#include <stdio.h>
namespace cg = cooperative_groups;

typedef unsigned short bf16_t;
#define DI __device__ __forceinline__

constexpr int NB = 4, SEQ = 4096, DM = 1024, LP = 4352, MP = NB * LP, OFF = 240;
constexpr float LOG2E = 1.4426950408889634f;
constexpr float ALPHA = 1.681792830507429f;
constexpr float QS64 = 0.125f * LOG2E;
constexpr float QS192 = 0.07216878364870323f * LOG2E;

DI float bf2f(bf16_t v) { return __uint_as_float(((unsigned)v) << 16); }
DI bf16_t f2bf(float f) { unsigned u = __float_as_uint(f); u += 0x7fffu + ((u >> 16) & 1u); return (bf16_t)(u >> 16); }
DI float lo16(unsigned v) { return __uint_as_float(v << 16); }
DI float hi16(unsigned v) { return __uint_as_float(v & 0xffff0000u); }
DI int opaque_tid() { int t = threadIdx.x; asm volatile("" : "+v"(t)); return t; }

struct Params {
  const float *x, *meta, *ln_g, *ln_b, *ev_w_in, *ev_w_out, *lq1, *lk1, *lq2, *lk2, *subln, *od_w_in, *od_qn, *od_w_uq, *od_kvn, *od_w_ukv, *od_w_out;
  float* out;
  bf16_t *W_evin, *W_evout, *W_odin, *W_oduq, *W_odukv, *W_odout;
  bf16_t *R0, *R1, *R2, *R3;
  float *hmeta, *rope, *lam, *rowss, *rsarr;
  unsigned* ctr;
  unsigned* bar;
  unsigned* pcnt;
  float* xch;
};

DI float* hrow(const Params& p, int b, int pp) {
  return pp >= 256 ? p.out + ((size_t)(b * SEQ + pp - 256)) * DM : p.hmeta + ((size_t)(b * 64 + pp - 192)) * DM;
}

DI int wmap(int mode, int n) {
  if (mode == 1) {
    if (n < 1024) return n;
    if (n < 1536) return n + 512;
    if (n < 2048) return n + 512;
    if (n < 2560) return n + 512;
    if (n < 3072) return n + 1024;
    if (n < 3584) return n - 2048;
    return n - 512;
  }
  if (mode == 2) {
    if (n < 768) return n;
    if (n < 1792) return n + 64;
    if (n < 1856) return n - 1024;
    return -1;
  }
  if (mode == 4) {
    if (n < 1024) return 256 * (n >> 7) + (n & 127);
    const int m = n - 1024; return 256 * (m >> 7) + 128 + (m & 127);
  }
  return n;
}
DI float wcolscale(int mode, int n) {
  if (mode == 1) return (n < 512 || (n >= 1536 && n < 2048)) ? QS64 : 1.0f;
  if (mode == 3) return QS192;
  return 1.0f;
}
constexpr int CT_EVIN = 1024, CT_EVOUT = 256, CT_ODIN = 512, CT_ODUQ = 192, CT_ODUKV = 128, CT_ODOUT = 256;
constexpr int CT_PER_LAYER = CT_EVIN + CT_EVOUT + CT_ODIN + CT_ODUQ + CT_ODUKV + CT_ODOUT;
constexpr int CT_TOTAL = 2 * CT_PER_LAYER;
struct ConvDesc { const float* W; bf16_t* Wt; const float* kscale; int K, Nsrc, mode, kt, nt; };
DI ConvDesc conv_desc(const Params& p, int t) {
  ConvDesc d; const int j = t / CT_PER_LAYER; int u = t % CT_PER_LAYER; d.kscale = nullptr;
  if (u < CT_EVIN) { d.W = p.ev_w_in + (size_t)j * 1024 * 4096; d.Wt = p.W_evin + (size_t)j * 4096 * 1024; d.K = 1024; d.Nsrc = 4096; d.mode = 1; d.kt = u & 15; d.nt = u >> 4; return d; }
  u -= CT_EVIN;
  if (u < CT_EVOUT) { d.W = p.ev_w_out + (size_t)j * 1024 * 1024; d.Wt = p.W_evout + (size_t)j * 1024 * 1024; d.K = 1024; d.Nsrc = 1024; d.mode = 0; d.kt = u & 15; d.nt = u >> 4; return d; }
  u -= CT_EVOUT;
  if (u < CT_ODIN) { d.W = p.od_w_in + (size_t)j * 1024 * 1856; d.Wt = p.W_odin + (size_t)j * 2048 * 1024; d.K = 1024; d.Nsrc = 1856; d.mode = 2; d.kt = u & 15; d.nt = u >> 4; return d; }
  u -= CT_ODIN;
  if (u < CT_ODUQ) { d.W = p.od_w_uq + (size_t)j * 512 * 1536; d.Wt = p.W_oduq + (size_t)j * 1536 * 512; d.K = 512; d.Nsrc = 1536; d.mode = 3; d.kscale = p.od_qn + j * 512; d.kt = u & 7; d.nt = u >> 3; return d; }
  u -= CT_ODUQ;
  if (u < CT_ODUKV) { d.W = p.od_w_ukv + (size_t)j * 256 * 2048; d.Wt = p.W_odukv + (size_t)j * 2048 * 256; d.K = 256; d.Nsrc = 2048; d.mode = 4; d.kscale = p.od_kvn + j * 256; d.kt = u & 3; d.nt = u >> 2; return d; }
  u -= CT_ODUKV;
  d.W = p.od_w_out + (size_t)j * 1024 * 1024; d.Wt = p.W_odout + (size_t)j * 1024 * 1024; d.K = 1024; d.Nsrc = 1024; d.mode = 0; d.kt = u & 15; d.nt = u >> 4; return d;
}
DI void conv_load(const ConvDesc& d, int tid, float4& v0, float4& v1) {
  const int src0 = wmap(d.mode, d.nt * 64); const int kk = tid >> 4, n4 = (tid & 15) * 4;
  v0 = make_float4(0.f, 0.f, 0.f, 0.f); v1 = v0;
  if (src0 >= 0) { const float* s = d.W + (size_t)(d.kt * 64 + kk) * d.Nsrc + src0 + n4; v0 = *(const float4*)s; v1 = *(const float4*)(s + (size_t)32 * d.Nsrc); }
}
DI void conv_all(const Params& p, float* lds, int tid) {
  int t = blockIdx.x; if (t >= CT_TOTAL) return;
  ConvDesc d = conv_desc(p, t); float4 v0, v1; conv_load(d, tid, v0, v1);
  for (;;) {
    { const int kk = tid >> 4, n4 = (tid & 15) * 4; float* a = lds + kk * 65 + n4; a[0] = v0.x; a[1] = v0.y; a[2] = v0.z; a[3] = v0.w; float* c = a + 32 * 65; c[0] = v1.x; c[1] = v1.y; c[2] = v1.z; c[3] = v1.w; }
    __syncthreads();
    const ConvDesc cur = d; const int tn = t + gridDim.x; const bool more = tn < CT_TOTAL;
    if (more) { d = conv_desc(p, tn); conv_load(d, tid, v0, v1); }
    { const float cs = wcolscale(cur.mode, cur.nt * 64); const int nn = tid >> 3, k8 = (tid & 7) * 8; const int k = cur.kt * 64 + k8;
      float v[8];
#pragma unroll
      for (int jj = 0; jj < 8; ++jj) { v[jj] = lds[(k8 + jj) * 65 + nn] * cs; if (cur.kscale) v[jj] *= cur.kscale[k + jj]; }
      uint4 o; o.x = (unsigned)f2bf(v[0]) | ((unsigned)f2bf(v[1]) << 16); o.y = (unsigned)f2bf(v[2]) | ((unsigned)f2bf(v[3]) << 16);
      o.z = (unsigned)f2bf(v[4]) | ((unsigned)f2bf(v[5]) << 16); o.w = (unsigned)f2bf(v[6]) | ((unsigned)f2bf(v[7]) << 16);
      *(uint4*)(cur.Wt + (size_t)(cur.nt * 64 + nn) * cur.K + k) = o; }
    __syncthreads();
    if (!more) break;
    t = tn;
  }
}
DI void prep_elem(const Params& p, size_t gtid, size_t gsize) {
  for (size_t i0 = gtid; i0 < (size_t)MP * 128; i0 += 4 * gsize) {
    float4 v0[4], v1[4]; int mm[4], cc[4], bb[4], pq[4];
#pragma unroll
    for (int k = 0; k < 4; ++k) { const size_t i = i0 + (size_t)k * gsize; const bool ok = i < (size_t)MP * 128;
      const int m = ok ? (int)(i >> 7) : 0, c8 = (int)(i & 127) * 8; const int b = m / LP, pp = ok ? m % LP : -1;
      mm[k] = m; cc[k] = c8; bb[k] = b; pq[k] = pp;
      v0[k] = make_float4(0.f, 0.f, 0.f, 0.f); v1[k] = v0[k];
      if (pp >= 256) { const float* sp = p.x + ((size_t)(b * SEQ + pp - 256)) * DM + c8; v0[k] = *(const float4*)sp; v1[k] = *(const float4*)(sp + 4); }
      else if (pp >= OFF) { const float* sp = p.meta + (size_t)(pp - OFF) * DM + c8; v0[k] = *(const float4*)sp; v1[k] = *(const float4*)(sp + 4); } }
#pragma unroll
    for (int k = 0; k < 4; ++k) { if (pq[k] < 0) continue;
      if (pq[k] >= 192 && pq[k] < 256) { float* hp = hrow(p, bb[k], pq[k]) + cc[k]; *(float4*)hp = v0[k]; *(float4*)(hp + 4) = v1[k]; }
      uint4 w; w.x = (unsigned)f2bf(v0[k].x) | ((unsigned)f2bf(v0[k].y) << 16); w.y = (unsigned)f2bf(v0[k].z) | ((unsigned)f2bf(v0[k].w) << 16);
      w.z = (unsigned)f2bf(v1[k].x) | ((unsigned)f2bf(v1[k].y) << 16); w.w = (unsigned)f2bf(v1[k].z) | ((unsigned)f2bf(v1[k].w) << 16);
      *(uint4*)(p.R0 + (size_t)mm[k] * DM + cc[k]) = w; }
  }
  for (size_t i = gtid; i < (size_t)LP * 32; i += gsize) {
    const int pp = (int)(i >> 5), f = (int)(i & 31); const int pos = pp >= OFF ? pp - OFF : 0;
    const float inv = powf(10000.0f, -(float)f / 32.0f);
    const float ang = (float)pos * inv;
    const double x = (double)ang; const double n = rint(x * 0.15915494309189535); const double r = x - n * 6.283185307179586;
    const float rf = (float)r;
    p.rope[(size_t)pp * 64 + f] = cosf(rf); p.rope[(size_t)pp * 64 + 32 + f] = sinf(rf);
  }
  if (gtid < 2) {
    const int j = (int)gtid; float d1 = 0.f, d2 = 0.f;
    for (int i = 0; i < 64; ++i) { d1 += p.lq1[j * 64 + i] * p.lk1[j * 64 + i]; d2 += p.lq2[j * 64 + i] * p.lk2[j * 64 + i]; }
    const float lam_init = 0.8f - 0.6f * expf(-0.3f * (float)(2 * j));
    p.lam[j * 2] = expf(d1) - expf(d2) + lam_init; p.lam[j * 2 + 1] = lam_init;
  }
  if (gtid < 128) p.ctr[gtid] = 0u;
}

__global__ void __launch_bounds__(256) k_prep(Params p) {
  __shared__ float lds[64 * 65];
  prep_elem(p, (size_t)blockIdx.x * 256 + threadIdx.x, (size_t)gridDim.x * 256);
}

DI float dotbf(const bf16_t* a, const bf16_t* w, int K) {
  float s = 0.f;
  for (int k = 0; k < K; k += 8) {
    const uint4 av = *(const uint4*)(a + k), wv = *(const uint4*)(w + k);
    s += lo16(av.x) * lo16(wv.x) + hi16(av.x) * hi16(wv.x) + lo16(av.y) * lo16(wv.y) + hi16(av.y) * hi16(wv.y)
       + lo16(av.z) * lo16(wv.z) + hi16(av.z) * hi16(wv.z) + lo16(av.w) * lo16(wv.w) + hi16(av.w) * hi16(wv.w);
  }
  return s;
}
DI float sumsq(const bf16_t* a, int K) { float s = 0.f; for (int k = 0; k < K; ++k) { const float v = bf2f(a[k]); s += v * v; } return s; }
DI float rope_apply(const float* rope, int pp, int d, float v, float v2) {
  const float c = rope[(size_t)pp * 64 + (d & 31)], s = rope[(size_t)pp * 64 + 32 + (d & 31)];
  return d < 32 ? v * c - v2 * s : v * c + v2 * s;
}
constexpr int NR = 4160;
template <int MODE> __global__ void __launch_bounds__(256) nv_gemm(Params p, int j) {
  constexpr int N = MODE == 0 ? 4096 : MODE == 1 ? 1856 : MODE == 2 ? 1536 : 2048;
  const size_t idx = (size_t)blockIdx.x * 256 + threadIdx.x;
  if (idx >= (size_t)NB * NR * N) return;
  const int n = (int)(idx % N); const int mi = (int)(idx / N); const int b = mi / NR, pp = 192 + mi % NR; const size_t m = (size_t)b * LP + pp;
  if (MODE == 0) {
    const float acc = dotbf(p.R0 + m * DM, p.W_evin + (size_t)j * 4096 * 1024 + (size_t)n * 1024, 1024);
    if (n < 3072) p.R2[m * 3072 + n] = f2bf(acc); else p.R1[((size_t)b * 1024 + n - 3072) * LP + pp] = f2bf(acc);
  } else if (MODE == 1) {
    const bf16_t* W = p.W_odin + (size_t)j * 2048 * 1024; const bf16_t* a = p.R0 + m * DM;
    const float acc = dotbf(a, W + (size_t)n * 1024, 1024);
    if (n < 768) p.R3[m * 768 + n] = f2bf(acc);
    else if (n < 1792) p.R2[m * 1024 + n - 768] = f2bf(acc);
    else { const int d = n - 1792; const float v2 = dotbf(a, W + (size_t)(1792 + (d ^ 32)) * 1024, 1024);
           p.R2[(size_t)MP * 2560 + m * 64 + d] = f2bf(rope_apply(p.rope, pp, d, acc, v2)); }
  } else if (MODE == 2) {
    const bf16_t* W = p.W_oduq + (size_t)j * 1536 * 512; const bf16_t* a = p.R3 + m * 768;
    const float rs = rsqrtf(sumsq(a, 512) * (1.0f / 512.0f) + 1e-6f);
    float v = dotbf(a, W + (size_t)n * 512, 512) * rs;
    const int dd = n % 192;
    if (dd >= 128) { const int d = dd - 128; const float v2 = dotbf(a, W + (size_t)(n - d + (d ^ 32)) * 512, 512) * rs; v = rope_apply(p.rope, pp, d, v, v2); }
    p.R2[(size_t)MP * 1024 + m * 1536 + n] = f2bf(v);
  } else {
    const bf16_t* W = p.W_odukv + (size_t)j * 2048 * 256; const bf16_t* a = p.R3 + m * 768 + 512;
    const float rs = rsqrtf(sumsq(a, 256) * (1.0f / 256.0f) + 1e-6f);
    const float v = dotbf(a, W + (size_t)n * 256, 256) * rs;
    if (n < 1024) p.R0[m * 1024 + n] = f2bf(v); else p.R1[((size_t)b * 1024 + n - 1024) * LP + pp] = f2bf(v);
  }
}
DI float wave_sum(float v) { for (int o = 32; o; o >>= 1) v += __shfl_xor(v, o); return v; }
DI float wave_max(float v) { for (int o = 32; o; o >>= 1) v = fmaxf(v, __shfl_xor(v, o)); return v; }
DI float silu(float g) { return g / (1.0f + __expf(-g)); }
template <int MODE> __global__ void __launch_bounds__(128) nv_attn(Params p, int j) {
  __shared__ float sc[2][2][LP];
  __shared__ float qs[2][192];
  constexpr int NH = MODE == 0 ? 4 : 8;
  const int wave = threadIdx.x >> 6, lane = threadIdx.x & 63;
  const int gq = blockIdx.x * 2 + wave; const int qi = gq % NR, bh = gq / NR; const int b = bh / NH, h = bh % NH; const int pp = 192 + qi;
  const size_t m = (size_t)b * LP + pp;
  const int kbeg = OFF; const int kend = MODE == 1 ? pp : (pp / 64 + 1) * 64;
  float* s0 = sc[wave][0]; float* s1 = sc[wave][1];
  if (MODE == 0) { for (int d = lane; d < 128; d += 64) qs[wave][d] = bf2f(p.R2[m * 3072 + 128 * h + d]); }
  if (MODE == 1) { qs[wave][lane] = bf2f(p.R2[m * 3072 + 1536 + 64 * h + lane]); }
  if (MODE == 2) { for (int d = lane; d < 192; d += 64) qs[wave][d] = bf2f(p.R2[(size_t)MP * 1024 + m * 1536 + 192 * h + d]); }
  __syncthreads();
  const float* q = qs[wave];
  for (int k = kbeg + lane; k < kend; k += 64) {
    const size_t mk = (size_t)b * LP + k;
    if (MODE == 0) {
      const bf16_t* kr = p.R2 + mk * 3072 + 512 + 128 * h; float a0 = 0.f, a1 = 0.f;
      for (int d = 0; d < 64; ++d) { a0 += q[d] * bf2f(kr[d]); a1 += q[64 + d] * bf2f(kr[64 + d]); }
      const float sl = exp2f(-2.0f * (float)(h + 1)) * LOG2E * fabsf((float)(pp - k));
      s0[k] = a0 - sl; s1[k] = a1 - sl;
    } else if (MODE == 1) {
      const bf16_t* kr = p.R2 + mk * 3072 + 2048 + 64 * h; float a0 = 0.f;
      for (int d = 0; d < 64; ++d) a0 += q[d] * bf2f(kr[d]);
      s0[k] = a0;
    } else {
      const bf16_t* kr = p.R0 + mk * 1024 + 128 * h; const bf16_t* kp = p.R2 + (size_t)MP * 2560 + mk * 64; float a0 = 0.f;
      for (int d = 0; d < 128; ++d) a0 += q[d] * bf2f(kr[d]);
      for (int d = 0; d < 64; ++d) a0 += q[128 + d] * bf2f(kp[d]);
      s0[k] = a0;
    }
  }
  __syncthreads();
  if (MODE == 1) {
    if (lane == 0) { float S = 0.f; for (int k = pp - 1; k >= kbeg; --k) { const float z = s0[k]; const float ls = -(fmaxf(z, 0.f) + log2f(1.0f + exp2f(-fabsf(z)))); S += ls; s0[k] = exp2f(z + S); } }
  } else {
    float m0 = -INFINITY, m1 = -INFINITY;
    for (int k = kbeg + lane; k < kend; k += 64) { m0 = fmaxf(m0, s0[k]); if (MODE == 0) m1 = fmaxf(m1, s1[k]); }
    m0 = wave_max(m0); if (MODE == 0) m1 = wave_max(m1);
    float l0 = 0.f, l1 = 0.f;
    for (int k = kbeg + lane; k < kend; k += 64) { l0 += exp2f(s0[k] - m0); if (MODE == 0) l1 += exp2f(s1[k] - m1); }
    l0 = wave_sum(l0); if (MODE == 0) l1 = wave_sum(l1);
    const float lam = MODE == 0 ? p.lam[2 * j] : 0.f;
    for (int k = kbeg + lane; k < kend; k += 64) {
      float w = exp2f(s0[k] - m0) / l0; if (MODE == 0) w -= lam * exp2f(s1[k] - m1) / l1;
      s0[k] = w;
    }
  }
  __syncthreads();
  if (MODE == 0) {
    float o[2];
    for (int t = 0; t < 2; ++t) { const int d = lane + 64 * t; const bf16_t* vr = p.R1 + ((size_t)b * 1024 + 128 * h + d) * LP; float a = 0.f; for (int k = kbeg; k < kend; ++k) a += s0[k] * bf2f(vr[k]); o[t] = a; }
    const float ss = wave_sum(o[0] * o[0] + o[1] * o[1]);
    const float r = rsqrtf(ss * (1.0f / 128.0f) + 1e-6f) * (1.0f - p.lam[2 * j + 1]);
    for (int t = 0; t < 2; ++t) { const int d = lane + 64 * t; const float g = bf2f(p.R2[m * 3072 + 1024 + 128 * h + d]);
      p.R0[m * 1024 + 128 * h + d] = f2bf(o[t] * r * p.subln[j * 128 + d] * silu(g)); }
  } else if (MODE == 1) {
    const int d = lane; const bf16_t* vr = p.R1 + ((size_t)b * 1024 + 512 + 64 * h + d) * LP; float a = 0.f;
    for (int k = kbeg; k < kend; ++k) a += s0[k] * bf2f(vr[k]);
    const float g = bf2f(p.R2[m * 3072 + 2560 + 64 * h + d]);
    p.R0[m * 1024 + 512 + 64 * h + d] = f2bf(a * silu(g));
  } else {
    for (int t = 0; t < 2; ++t) { const int d = lane + 64 * t; const bf16_t* vr = p.R1 + ((size_t)b * 1024 + 128 * h + d) * LP; float a = 0.f; for (int k = kbeg; k < kend; ++k) a += s0[k] * bf2f(vr[k]);
      const float g = bf2f(p.R2[m * 1024 + 128 * h + d]);
      p.R3[m * 1024 + 128 * h + d] = f2bf(a * silu(g)); }
  }
}
__global__ void __launch_bounds__(256) nv_out_ln(Params p, int layer, const bf16_t* Y, const bf16_t* Wt) {
  __shared__ float red[8];
  const int mi = blockIdx.x; const int b = mi / NR, pp = 192 + mi % NR; const size_t m = (size_t)b * LP + pp;
  const int tid = threadIdx.x, lane = tid & 63, wave = tid >> 6;
  float* hr = hrow(p, b, pp);
  float z[4]; float s = 0.f;
  for (int i = 0; i < 4; ++i) { const int n = tid + 256 * i; z[i] = ALPHA * hr[n] + dotbf(Y + m * 1024, Wt + (size_t)n * 1024, 1024); s += z[i]; }
  s = wave_sum(s); if (lane == 0) red[wave] = s; __syncthreads();
  const float mean = (red[0] + red[1] + red[2] + red[3]) * (1.0f / 1024.0f);
  float v = 0.f; for (int i = 0; i < 4; ++i) { const float d = z[i] - mean; v += d * d; }
  v = wave_sum(v); if (lane == 0) red[4 + wave] = v; __syncthreads();
  const float rstd = rsqrtf((red[4] + red[5] + red[6] + red[7]) * (1.0f / 1024.0f) + 1e-5f);
  for (int i = 0; i < 4; ++i) { const int n = tid + 256 * i; const float o = (z[i] - mean) * rstd * p.ln_g[layer * 1024 + n] + p.ln_b[layer * 1024 + n]; hr[n] = o; p.R0[m * 1024 + n] = f2bf(o); }
}


typedef short bf16x8 __attribute__((ext_vector_type(8)));
typedef short s16x4 __attribute__((ext_vector_type(4)));
typedef float f32x16 __attribute__((ext_vector_type(16)));
typedef __bf16 bf2_t __attribute__((ext_vector_type(2)));
typedef float f2_t __attribute__((ext_vector_type(2)));
#define MFMA32(a, b, c) __builtin_amdgcn_mfma_f32_32x32x16_bf16((a), (b), (c), 0, 0, 0)
DI unsigned pk2(float a, float b) { f2_t v = {a, b}; bf2_t r = __builtin_convertvector(v, bf2_t); return __builtin_bit_cast(unsigned, r); }
DI uint2 pk4(float a, float b, float c, float d) { uint2 r; r.x = pk2(a, b); r.y = pk2(c, d); return r; }
DI float ex2(float x) { return __builtin_amdgcn_exp2f(x); }
DI float lg2(float x) { return __builtin_amdgcn_logf(x); }
DI float silu_f(float g) { return g * __builtin_amdgcn_rcpf(1.0f + ex2(-g * LOG2E)); }
DI bf16x8 pack_step(const f32x16& x, int s) {
  uint4 u; u.x = pk2(x[8 * s], x[8 * s + 1]); u.y = pk2(x[8 * s + 2], x[8 * s + 3]); u.z = pk2(x[8 * s + 4], x[8 * s + 5]); u.w = pk2(x[8 * s + 6], x[8 * s + 7]);
  return __builtin_bit_cast(bf16x8, u);
}
DI bf16x8 ld_frag(const char* a) { return *(const bf16x8*)a; }
DI void store_pair16(bf16_t* rowp, int colbase, int hh, uint2 a, uint2 b) {
  const auto r0 = __builtin_amdgcn_permlane32_swap(a.x, b.x, false, false), r1 = __builtin_amdgcn_permlane32_swap(a.y, b.y, false, false);
  uint4 o; o.x = r0[0]; o.y = r1[0]; o.z = r0[1]; o.w = r1[1];
  *(uint4*)(rowp + colbase + 8 * hh) = o;
}
DI float x32_max(float x) { auto rr = __builtin_amdgcn_permlane32_swap(__float_as_uint(x), __float_as_uint(x), false, false); return fmaxf(__uint_as_float(rr[0]), __uint_as_float(rr[1])); }
DI float x32_sum(float x) { auto rr = __builtin_amdgcn_permlane32_swap(__float_as_uint(x), __float_as_uint(x), false, false); return __uint_as_float(rr[0]) + __uint_as_float(rr[1]); }
DI bf16x8 ld_vfrag(const char* a) {
  const uint2 lo = *(const uint2*)a, hi = *(const uint2*)(a + 16); uint4 u; u.x = lo.x; u.y = lo.y; u.z = hi.x; u.w = hi.y; return __builtin_bit_cast(bf16x8, u);
}
constexpr int SMEM_BYTES = 133120, SM_SLOT = 132608;
constexpr int NTHR = 512;

namespace pg8 {
#define PG8_LAS __attribute__((address_space(3)))
typedef unsigned short bf16_t;
typedef short bf16x8 __attribute__((ext_vector_type(8)));
typedef float f32x4 __attribute__((ext_vector_type(4)));
typedef unsigned u32x4 __attribute__((ext_vector_type(4)));
constexpr int BM = 256, BK = 64, HALF = 128, HTB = HALF * BK * 2  , STAGE_BYTES = 8 * HTB, NXCD = 8, WGM = 8;

__host__ __device__ __forceinline__ int lds_byte(int r, int c) { const int st = (r >> 4) * 2 + (c >> 5), rr = r & 15, cc = c & 31, ob = rr * 64 + cc * 2; return st * 1024 + (ob ^ (((ob >> 9) & 1) << 5)); }
__host__ __device__ __forceinline__ void stage_rc(int b, int& R, int& C) { const int st = b / 1024, sb = b % 1024, swz = sb ^ (((sb >> 9) & 1) << 5); R = (st >> 1) * 16 + swz / 64; C = (st & 1) * 32 + (swz % 64) / 2; }
__host__ __device__ __forceinline__ int perm32(int rho) { const int n = rho >> 4, i = rho & 15; return 8 * (i >> 2) + 4 * n + (i & 3); }

struct Unit { int pm, pn; };
struct Gemm { const bf16_t* A; const bf16_t* Bt; int M, N, K; };

struct StaticOrder {
    int nM, nN, nwg, G, c;
    __host__ __device__ void init(int M, int N, int G_, int c_) { nM = M / BM; nN = N / BM; nwg = nM * nN; G = G_; c = c_; }
    __host__ __device__ bool next(int i, Unit& u) const {
        const long L = (long)i * G + c; if (L >= nwg) return false;
        int wgid = (int)L; { const int q = nwg / NXCD, r = nwg % NXCD, xcd = wgid % NXCD, off = wgid / NXCD; wgid = (xcd < r ? xcd * (q + 1) : r * (q + 1) + (xcd - r) * q) + off; }
        const int nig = WGM * nN, gid = wgid / nig, fm = gid * WGM, gsz = (nM - fm) < WGM ? (nM - fm) : WGM;
        u.pm = fm + ((wgid % nig) % gsz); u.pn = (wgid % nig) / gsz; return true;
    }
    __device__ __forceinline__ void a_ready(const Unit&) const {}
    __device__ __forceinline__ void done(const Unit&) const {}
};


struct FrameOrder {
    StaticOrder S;
    __device__ __forceinline__ void init(int nN, int G, int c) { S.nM = 64; S.nN = nN; S.nwg = 64 * nN; S.G = G; S.c = c; }
    __device__ __forceinline__ bool next(int i, Unit& u) const { if (!S.next(i, u)) return false; u.pm = (u.pm >> 4) * 17 + 1 + (u.pm & 15); return true; }
    __device__ __forceinline__ void a_ready(const Unit&) const {}
    __device__ __forceinline__ void done(const Unit&) const {}
};
struct ListOrder {
    int cnt, base, stride, nN;
    __device__ __forceinline__ bool next(int i, Unit& u) const { if (i >= cnt) return false; const int L = base + i * stride; const int pmf = L / nN; u.pn = L % nN; u.pm = (pmf >> 4) * 17 + 1 + (pmf & 15); return true; }
    __device__ __forceinline__ void a_ready(const Unit&) const {}
    __device__ __forceinline__ void done(const Unit&) const {}
};
template <int SUB> struct EpiMix {
    static constexpr bool PERM = true, AFTER_DRAIN = false;
    const Params* pp_; int first;
    __device__ __forceinline__ void vt_store(bf16_t* vt, const u32x4 w) const {
        vt[0] = (bf16_t)w.x; vt[LP] = (bf16_t)(w.x >> 16); vt[2 * LP] = (bf16_t)w.y; vt[3 * LP] = (bf16_t)(w.y >> 16);
        vt[4 * LP] = (bf16_t)w.z; vt[5 * LP] = (bf16_t)(w.z >> 16); vt[6 * LP] = (bf16_t)w.w; vt[7 * LP] = (bf16_t)(w.w >> 16); }
    __device__ __forceinline__ void operator()(const f32x4 (&acc)[2][2][4][2], const Unit& u, int wr, int wc, int fr_, int fq_) const {
        const Params& p = *pp_;
        const int t_ = opaque_tid(), fr = t_ & 15, fq = (t_ >> 4) & 3;
        const int b = u.pm / 17, ppb = (u.pm % 17) * 256 + wr * 64 + fr, c8 = 8 * fq;
#pragma unroll
        for (int ai = 0; ai < 2; ++ai)
#pragma unroll
            for (int m = 0; m < 4; ++m) {
                const int pp = ppb + ai * 128 + m * 16; const size_t mrow = (size_t)b * LP + pp;
                float rs = 1.0f;
                if (SUB == 2) rs = p.rsarr[mrow * 2];
                if (SUB == 3) rs = p.rsarr[mrow * 2 + 1];
#pragma unroll
                for (int bj = 0; bj < 2; ++bj) {
                    const int cg = u.pn * 256 + bj * 128 + wc * 32;
                    const f32x4 v0 = acc[ai][bj][m][0] * rs, v1 = acc[ai][bj][m][1] * rs;
                    if (SUB == 4) {
                        const size_t ho = ((size_t)(b * SEQ + pp - 256)) * DM + cg + c8; float* hr = p.out + ho; const float* hs = (first ? p.x : p.out) + ho;
                        const f32x4 h0 = *(const f32x4*)hs, h1 = *(const f32x4*)(hs + 4);
                        *(f32x4*)hr = h0 * ALPHA + v0; *(f32x4*)(hr + 4) = h1 * ALPHA + v1;
                    } else {
                        u32x4 w; w.x = pk2(v0[0], v0[1]); w.y = pk2(v0[2], v0[3]); w.z = pk2(v1[0], v1[1]); w.w = pk2(v1[2], v1[3]);
                        if (SUB == 0) {
                            if (cg < 3072) { *(u32x4*)(p.R2 + mrow * 3072 + cg + c8) = w;
                                if (cg >= 512 && cg < 1024) {
                                    float ss = (v0[0] * v0[0] + v0[1] * v0[1]) + (v0[2] * v0[2] + v0[3] * v0[3]) + (v1[0] * v1[0] + v1[1] * v1[1]) + (v1[2] * v1[2] + v1[3] * v1[3]);
                                    ss += __shfl_xor(ss, 16); ss += __shfl_xor(ss, 32);
                                    if (fq == 0) p.rowss[mrow * 24 + ((cg - 512) >> 5)] = ss; } }
                            else vt_store(p.R1 + ((size_t)b * 1024 + (cg - 3072 + c8)) * LP + pp, w);
                        } else if (SUB == 1) {
                            if (cg < 768) {
                                if (cg < 512) *(u32x4*)(p.R3 + mrow * 512 + cg + c8) = w; else *(u32x4*)(p.R3 + (size_t)MP * 512 + mrow * 256 + (cg - 512) + c8) = w;
                                float ss = (v0[0] * v0[0] + v0[1] * v0[1]) + (v0[2] * v0[2] + v0[3] * v0[3]) + (v1[0] * v1[0] + v1[1] * v1[1]) + (v1[2] * v1[2] + v1[3] * v1[3]);
                                ss += __shfl_xor(ss, 16); ss += __shfl_xor(ss, 32);
                                if (fq == 0) p.rowss[mrow * 24 + (cg >> 5)] = ss;
                            } else if (cg < 1792) *(u32x4*)(p.R2 + mrow * 1024 + (cg - 768) + c8) = w;
                            else if (cg < 1856) *(u32x4*)(p.R2 + (size_t)MP * 2624 + mrow * 64 + (cg - 1792) + c8) = w;
                        } else if (SUB == 2) {
                            *(u32x4*)(p.R2 + (size_t)MP * 1024 + mrow * 1536 + cg + c8) = w;
                        } else {
                            if (cg < 1024) *(u32x4*)(p.R0 + mrow * 1024 + cg + c8) = w;
                            else vt_store(p.R1 + ((size_t)b * 1024 + (cg - 1024 + c8)) * LP + pp, w);
                        }
                    }
                }
            }
    }
};
struct EpiOutLn {
    static constexpr bool PERM = true, AFTER_DRAIN = true;
    const Params* pp_; int first, layer;
    __device__ __forceinline__ void fused(f32x4 (&acc)[2][2][4][2], const Unit& u, int wr, int wc, int fr_, int fq_, PG8_LAS unsigned char* ldsp, int wid, int lane_) const {
        const Params& p = *pp_;
        char* sm = (char*)ldsp;
        float2* part = (float2*)sm;
        float2* tab = (float2*)(sm + 8192);
        const int t_ = opaque_tid(), fr = t_ & 15, fq = (t_ >> 4) & 3, c8 = 8 * fq;
        const int b = u.pm / 17, pp0 = (u.pm % 17) * 256;
        const float* hsrc = first ? p.x : p.out;
#pragma unroll
        for (int ai = 0; ai < 2; ++ai)
#pragma unroll
            for (int m = 0; m < 4; ++m) {
                const int rowl = ai * 128 + wr * 64 + m * 16 + fr; const size_t ho = ((size_t)(b * SEQ + pp0 + rowl - 256)) * DM + u.pn * 256 + wc * 32 + c8;
                float s1 = 0.f, s2 = 0.f;
#pragma unroll
                for (int bj = 0; bj < 2; ++bj) {
                    const f32x4 h0 = *(const f32x4*)(hsrc + ho + bj * 128), h1 = *(const f32x4*)(hsrc + ho + bj * 128 + 4);
                    const f32x4 z0 = h0 * ALPHA + acc[ai][bj][m][0], z1 = h1 * ALPHA + acc[ai][bj][m][1];
                    acc[ai][bj][m][0] = z0; acc[ai][bj][m][1] = z1;
                    s1 += ((z0[0] + z0[1]) + (z0[2] + z0[3])) + ((z1[0] + z1[1]) + (z1[2] + z1[3]));
                    s2 += ((z0[0] * z0[0] + z0[1] * z0[1]) + (z0[2] * z0[2] + z0[3] * z0[3])) + ((z1[0] * z1[0] + z1[1] * z1[1]) + (z1[2] * z1[2] + z1[3] * z1[3]));
                }
                s1 += __shfl_xor(s1, 16); s1 += __shfl_xor(s1, 32); s2 += __shfl_xor(s2, 16); s2 += __shfl_xor(s2, 32);
                if (fq == 0) part[wc * 256 + rowl] = make_float2(s1, s2);
            }
        __syncthreads();
        unsigned long long* xch = (unsigned long long*)p.xch + (size_t)u.pm * 1024;
        if (t_ < 256) { const float2 a = part[t_], b2 = part[256 + t_], c2 = part[512 + t_], d2 = part[768 + t_];
            const float S1 = (a.x + b2.x) + (c2.x + d2.x), S2 = (a.y + b2.y) + (c2.y + d2.y);
            __hip_atomic_store(xch + t_ * 4 + u.pn, ((unsigned long long)__float_as_uint(S2) << 32) | __float_as_uint(S1), __ATOMIC_RELAXED, __HIP_MEMORY_SCOPE_AGENT); }
        asm volatile("s_waitcnt vmcnt(0)" ::: "memory"); __syncthreads();
        unsigned* cnt = p.pcnt + (layer * 68 + u.pm) * 16;
        if (t_ == 0) { __hip_atomic_fetch_add(cnt, 1u, __ATOMIC_RELAXED, __HIP_MEMORY_SCOPE_AGENT);
            for (unsigned sp = 0; __hip_atomic_load(cnt, __ATOMIC_RELAXED, __HIP_MEMORY_SCOPE_AGENT) < 4u && sp < (1u << 22); ++sp) __builtin_amdgcn_s_sleep(2); }
        __syncthreads();
        if (t_ < 256) { float S1 = 0.f, S2 = 0.f;
#pragma unroll
            for (int k = 0; k < 4; ++k) { const unsigned long long v = __hip_atomic_load(xch + t_ * 4 + k, __ATOMIC_RELAXED, __HIP_MEMORY_SCOPE_AGENT); S1 += __uint_as_float((unsigned)v); S2 += __uint_as_float((unsigned)(v >> 32)); }
            const float mean = S1 * (1.0f / 1024.0f); tab[t_] = make_float2(mean, rsqrtf(fmaxf(S2 * (1.0f / 1024.0f) - mean * mean, 0.f) + 1e-5f)); }
        __syncthreads();
        const float* lg = p.ln_g + layer * 1024 + u.pn * 256 + wc * 32 + c8; const float* lb = p.ln_b + layer * 1024 + u.pn * 256 + wc * 32 + c8;
#pragma unroll
        for (int bj = 0; bj < 2; ++bj) {
            const f32x4 g0 = *(const f32x4*)(lg + bj * 128), g1 = *(const f32x4*)(lg + bj * 128 + 4), b0 = *(const f32x4*)(lb + bj * 128), b1 = *(const f32x4*)(lb + bj * 128 + 4);
#pragma unroll
            for (int ai = 0; ai < 2; ++ai)
#pragma unroll
                for (int m = 0; m < 4; ++m) {
                    const int rowl = ai * 128 + wr * 64 + m * 16 + fr; const float2 mr = tab[rowl];
                    const size_t mrow = (size_t)b * LP + pp0 + rowl; const size_t ho = ((size_t)(b * SEQ + pp0 + rowl - 256)) * DM + u.pn * 256 + wc * 32 + c8 + bj * 128;
                    const f32x4 o0 = (acc[ai][bj][m][0] - mr.x) * mr.y * g0 + b0, o1 = (acc[ai][bj][m][1] - mr.x) * mr.y * g1 + b1;
                    *(f32x4*)(p.out + ho) = o0; *(f32x4*)(p.out + ho + 4) = o1;
                    u32x4 w; w.x = pk2(o0[0], o0[1]); w.y = pk2(o0[2], o0[3]); w.z = pk2(o1[0], o1[1]); w.w = pk2(o1[2], o1[3]);
                    *(u32x4*)(p.R0 + mrow * 1024 + u.pn * 256 + wc * 32 + c8 + bj * 128) = w;
                }
        }
    }
};
template <class Epi, class Sched, bool ALIGN_EPI = false, bool SP2 = false>
__device__ __forceinline__ void gemm_phase(PG8_LAS unsigned char* lds, const Gemm g, const Sched& S, const Epi& E) {
    const int tid = opaque_tid(), wid = __builtin_amdgcn_readfirstlane(tid >> 6), lane = tid & 63, wr = wid >> 2, wc = wid & 3, fr = lane & 15, fq = lane >> 4;
    const int K = g.K, nt = K / BK;
    unsigned voffA[2], voffB[2];
#pragma unroll
    for (int i = 0; i < 2; ++i) { int R, C; stage_rc(tid * 16 + i * 8192, R, C); const int Rb = Epi::PERM ? ((R & ~31) + perm32(R & 31)) : R;
        voffA[i] = (unsigned)(R * K + C) * 2u; voffB[i] = (unsigned)(Rb * K + C) * 2u; }
    const size_t kstep = (size_t)(BK * 2);
    const size_t hstep = (size_t)HALF * K * 2;
    const size_t tstep = 2 * hstep;
    const unsigned ldsw = (unsigned)wid * 1024u;
    const int aoff = lds_byte(wr * 64 + fr, fq * 8), boff = lds_byte(wc * 32 + fr, fq * 8);
#define PG8_SA(b, h) (((b) * 2 + (h)) * HTB)
#define PG8_SB(b, h) ((4 + (b) * 2 + (h)) * HTB)
#define PG8_STAGE(bufoff, gbase, voff) do { _Pragma("unroll") for (int _i = 0; _i < 2; ++_i) \
        __builtin_amdgcn_global_load_lds((const unsigned*)((const char*)(gbase) + (voff)[_i]), (PG8_LAS unsigned*)(lds + (bufoff) + ldsw + _i * 8192), 16, 0, 0); } while (0)
#define PG8_LDA(dst, b, h) do { _Pragma("unroll") for (int m = 0; m < 4; ++m) _Pragma("unroll") for (int k = 0; k < 2; ++k) dst[m][k] = *(const PG8_LAS bf16x8*)(lds + PG8_SA(b, h) + aoff + m * 2048 + k * 1024); } while (0)
#define PG8_LDB(dst, b, h) do { _Pragma("unroll") for (int n = 0; n < 2; ++n) _Pragma("unroll") for (int k = 0; k < 2; ++k) dst[n][k] = *(const PG8_LAS bf16x8*)(lds + PG8_SB(b, h) + boff + n * 2048 + k * 1024); } while (0)
#define PG8_MMA(ai, bj, At, Bt) do { __builtin_amdgcn_s_setprio(1); _Pragma("unroll") for (int m = 0; m < 4; ++m) _Pragma("unroll") for (int n = 0; n < 2; ++n) _Pragma("unroll") for (int k = 0; k < 2; ++k) \
        acc[ai][bj][m][n] = __builtin_amdgcn_mfma_f32_16x16x32_bf16(Bt[n][k], At[m][k], acc[ai][bj][m][n], 0, 0, 0); __builtin_amdgcn_s_setprio(0); } while (0)
#define PG8_WAIT_V(n) asm volatile("s_waitcnt vmcnt(" #n ")" ::: "memory")
#define PG8_WAIT_L(n) asm volatile("s_waitcnt lgkmcnt(" #n ")" ::: "memory")
#define PG8_BAR __builtin_amdgcn_s_barrier()
#define PG8_SCHED __builtin_amdgcn_sched_barrier(0)
    Unit cur, nxt; int ui = 0;
    if (!S.next(0, cur)) return;
    f32x4 acc[2][2][4][2];
#pragma unroll
    for (int a = 0; a < 2; ++a)
#pragma unroll
        for (int b = 0; b < 2; ++b)
#pragma unroll
            for (int m = 0; m < 4; ++m)
#pragma unroll
                for (int n = 0; n < 2; ++n) acc[a][b][m][n] = (f32x4){0.f, 0.f, 0.f, 0.f};
    bf16x8 At[4][2], B0[2][2], B1[2][2];
    const char* cA = (const char*)g.A + (size_t)cur.pm * tstep; const char* cB = (const char*)g.Bt + (size_t)cur.pn * tstep;
    S.a_ready(cur);
    if constexpr (SP2) {
        PG8_STAGE(PG8_SB(0, 0), cB, voffB); PG8_STAGE(PG8_SB(0, 1), cB + hstep, voffB); PG8_STAGE(PG8_SA(0, 0), cA, voffA); PG8_STAGE(PG8_SA(0, 1), cA + hstep, voffA);
        if (wr == 1) PG8_BAR;
        PG8_WAIT_V(2); PG8_BAR;
        PG8_STAGE(PG8_SB(1, 0), cB + kstep, voffB); PG8_STAGE(PG8_SA(1, 0), cA + kstep, voffA); PG8_STAGE(PG8_SB(1, 1), cB + hstep + kstep, voffB);
        PG8_WAIT_V(6); PG8_BAR;
    } else {
        PG8_STAGE(PG8_SB(0, 0), cB, voffB); PG8_STAGE(PG8_SA(0, 0), cA, voffA); PG8_STAGE(PG8_SB(0, 1), cB + hstep, voffB); PG8_STAGE(PG8_SA(0, 1), cA + hstep, voffA);
        if (wr == 1) PG8_BAR;
        PG8_WAIT_V(4); PG8_BAR;
        PG8_STAGE(PG8_SB(1, 0), cB + kstep, voffB); PG8_STAGE(PG8_SA(1, 0), cA + kstep, voffA); PG8_STAGE(PG8_SB(1, 1), cB + hstep + kstep, voffB);
        PG8_WAIT_V(6); PG8_BAR;
    }
    for (;;) {
        const bool has_next = S.next(ui + 1, nxt);
        const char* nA = has_next ? (const char*)g.A + (size_t)nxt.pm * tstep : cA; const char* nB = has_next ? (const char*)g.Bt + (size_t)nxt.pn * tstep : cB;
        for (int t = 0; t < nt; t += 2) {
            const bool last = (t == nt - 2);
            const char* a1 = cA + (size_t)(t + 1) * kstep;
            const char* a2 = last ? nA : cA + (size_t)(t + 2) * kstep; const char* b2 = last ? nB : cB + (size_t)(t + 2) * kstep;
            const char* a3 = a2 + kstep; const char* b3 = b2 + kstep;
            if (last && has_next) S.a_ready(nxt);
            if constexpr (SP2) {
            PG8_LDB(B0, 0, 0); PG8_LDB(B1, 0, 1); PG8_SCHED; PG8_LDA(At, 0, 0); PG8_STAGE(PG8_SA(1, 1), a1 + hstep, voffA);
            PG8_WAIT_V(8); PG8_WAIT_L(0); PG8_BAR; PG8_MMA(0, 0, At, B0); PG8_MMA(0, 1, At, B1); PG8_BAR; PG8_SCHED;
            PG8_LDA(At, 0, 1); PG8_STAGE(PG8_SB(0, 0), b2, voffB); PG8_STAGE(PG8_SB(0, 1), b2 + hstep, voffB); PG8_STAGE(PG8_SA(0, 0), a2, voffA);
            PG8_WAIT_V(8); PG8_WAIT_L(0); PG8_BAR; PG8_MMA(1, 0, At, B0); PG8_MMA(1, 1, At, B1); PG8_BAR; PG8_SCHED;
            PG8_LDB(B0, 1, 0); PG8_LDB(B1, 1, 1); PG8_SCHED; PG8_LDA(At, 1, 0); PG8_STAGE(PG8_SA(0, 1), a2 + hstep, voffA);
            PG8_WAIT_V(8); PG8_WAIT_L(0); PG8_BAR; PG8_MMA(0, 0, At, B0); PG8_MMA(0, 1, At, B1); PG8_BAR; PG8_SCHED;
            PG8_LDA(At, 1, 1); PG8_STAGE(PG8_SB(1, 0), b3, voffB); PG8_STAGE(PG8_SB(1, 1), b3 + hstep, voffB); PG8_STAGE(PG8_SA(1, 0), a3, voffA);
            PG8_WAIT_V(8); PG8_WAIT_L(0); PG8_BAR; PG8_MMA(1, 0, At, B0); PG8_MMA(1, 1, At, B1); PG8_BAR; PG8_SCHED;
            } else {
            PG8_LDB(B0, 0, 0); PG8_SCHED; PG8_LDA(At, 0, 0); PG8_STAGE(PG8_SA(1, 1), a1 + hstep, voffA);
            PG8_WAIT_L(8); PG8_BAR; PG8_WAIT_L(0); PG8_MMA(0, 0, At, B0); PG8_BAR; PG8_SCHED;
            PG8_LDB(B1, 0, 1); PG8_STAGE(PG8_SB(0, 0), b2, voffB);
            PG8_BAR; PG8_WAIT_L(0); PG8_MMA(0, 1, At, B1); PG8_BAR;
            PG8_LDA(At, 0, 1); PG8_STAGE(PG8_SA(0, 0), a2, voffA);
            PG8_BAR; PG8_WAIT_L(0); PG8_MMA(1, 0, At, B0); PG8_BAR; PG8_SCHED;
            PG8_STAGE(PG8_SB(0, 1), b2 + hstep, voffB);
            PG8_WAIT_V(6); PG8_BAR; PG8_MMA(1, 1, At, B1); PG8_BAR;
            PG8_LDB(B0, 1, 0); PG8_SCHED; PG8_LDA(At, 1, 0); PG8_STAGE(PG8_SA(0, 1), a2 + hstep, voffA);
            PG8_WAIT_L(8); PG8_BAR; PG8_WAIT_L(0); PG8_MMA(0, 0, At, B0); PG8_BAR; PG8_SCHED;
            PG8_LDB(B1, 1, 1); PG8_STAGE(PG8_SB(1, 0), b3, voffB);
            PG8_BAR; PG8_WAIT_L(0); PG8_MMA(0, 1, At, B1); PG8_BAR;
            PG8_LDA(At, 1, 1); PG8_STAGE(PG8_SA(1, 0), a3, voffA);
            PG8_BAR; PG8_WAIT_L(0); PG8_MMA(1, 0, At, B0); PG8_BAR; PG8_SCHED;
            PG8_STAGE(PG8_SB(1, 1), b3 + hstep, voffB);
            PG8_WAIT_V(6); PG8_BAR; PG8_MMA(1, 1, At, B1); PG8_BAR;
            }
        }
        if constexpr (ALIGN_EPI) { if (wr == 0) PG8_BAR; }
        if constexpr (!Epi::AFTER_DRAIN) { E(acc, cur, wr, wc, fr, fq); S.done(cur); }
        if (!has_next) break;
#pragma unroll
        for (int a = 0; a < 2; ++a)
#pragma unroll
            for (int b = 0; b < 2; ++b)
#pragma unroll
                for (int m = 0; m < 4; ++m)
#pragma unroll
                    for (int n = 0; n < 2; ++n) acc[a][b][m][n] = (f32x4){0.f, 0.f, 0.f, 0.f};
        cur = nxt; cA = nA; cB = nB; ++ui;
        if constexpr (ALIGN_EPI) { if (wr == 1) PG8_BAR; }
    }
    PG8_WAIT_V(0);
    if constexpr (!ALIGN_EPI) { if (wr == 0) PG8_BAR; }
    PG8_BAR;
    if constexpr (Epi::AFTER_DRAIN) { E.fused(acc, cur, wr, wc, fr, fq, lds, wid, lane); S.done(cur); }
#undef PG8_SA
#undef PG8_SB
#undef PG8_STAGE
#undef PG8_LDA
#undef PG8_LDB
#undef PG8_MMA
#undef PG8_WAIT_V
#undef PG8_WAIT_L
#undef PG8_BAR
#undef PG8_SCHED
}
}

constexpr int META_LD = 2064;
DI void meta_gemm(const Params& p, int sub, int j, int layer, char* smem) {
  const int tid = opaque_tid(), lane = tid & 63, nl = tid >> 6;
  const bf16_t* A; const bf16_t* W; int K, N;
  if (sub == 0) { A = p.R0; K = 1024; N = 4096; W = p.W_evin + (size_t)j * 4096 * 1024; }
  else if (sub == 1) { A = p.R0; K = 1024; N = 1856; W = p.W_odin + (size_t)j * 2048 * 1024; }
  else if (sub == 2) { A = p.R3; K = 512; N = 1536; W = p.W_oduq + (size_t)j * 1536 * 512; }
  else if (sub == 3) { A = p.R3 + (size_t)MP * 512; K = 256; N = 2048; W = p.W_odukv + (size_t)j * 2048 * 256; }
  else { A = (layer & 1) ? p.R3 : p.R0; K = 1024; N = 1024; W = ((layer & 1) ? p.W_odout : p.W_evout) + (size_t)j * 1024 * 1024; }
  const int kch = K >> 3;
  if (sub <= 1 && layer > 0) {
    const int wv = tid >> 6; const float* lg = p.ln_g + (layer - 1) * 1024; const float* lb = p.ln_b + (layer - 1) * 1024;
    for (int row = wv; row < 64; row += 8) {
      const float* zr = p.hmeta + ((size_t)((row >> 4) * 64 + (row & 15))) * DM; float* hr = p.hmeta + ((size_t)((row >> 4) * 64 + 48 + (row & 15))) * DM;
      float4 z[4]; float s1 = 0.f;
#pragma unroll
      for (int i = 0; i < 4; ++i) { z[i] = *(const float4*)(zr + 256 * i + 4 * lane); s1 += (z[i].x + z[i].y) + (z[i].z + z[i].w); }
      const float mean = wave_sum(s1) * (1.0f / 1024.0f); float s2 = 0.f;
#pragma unroll
      for (int i = 0; i < 4; ++i) { const float a = z[i].x - mean, b2 = z[i].y - mean, c2 = z[i].z - mean, d2 = z[i].w - mean; s2 += (a * a + b2 * b2) + (c2 * c2 + d2 * d2); }
      const float rstd = rsqrtf(wave_sum(s2) * (1.0f / 1024.0f) + 1e-5f);
#pragma unroll
      for (int i = 0; i < 4; ++i) { const int n = 256 * i + 4 * lane; const float4 g = *(const float4*)(lg + n), bb = *(const float4*)(lb + n);
        float4 o; o.x = (z[i].x - mean) * rstd * g.x + bb.x; o.y = (z[i].y - mean) * rstd * g.y + bb.y; o.z = (z[i].z - mean) * rstd * g.z + bb.z; o.w = (z[i].w - mean) * rstd * g.w + bb.w;
        *(uint2*)(smem + row * META_LD + n * 2) = pk4(o.x, o.y, o.z, o.w);
        if (blockIdx.x == 0) *(float4*)(hr + n) = o; }
    }
  } else {
    for (int c = tid; c < 64 * kch; c += NTHR) { const int row = c / kch, kc = c % kch; const size_t m = (size_t)(row >> 4) * LP + OFF + (row & 15);
      *(uint4*)(smem + row * META_LD + kc * 16) = *(const uint4*)(A + m * K + kc * 8); }
  }
  __syncthreads();
  const int b = lane >> 4, pp = OFF + (lane & 15); const size_t m = (size_t)b * LP + pp;
  const char* ar = smem + lane * META_LD;
  float rs = 1.0f;
  if (sub == 2 || sub == 3) { float ss = 0.f; for (int kc = 0; kc < kch; ++kc) { const uint4 v = *(const uint4*)(ar + kc * 16);
      ss += lo16(v.x) * lo16(v.x) + hi16(v.x) * hi16(v.x) + lo16(v.y) * lo16(v.y) + hi16(v.y) * hi16(v.y) + lo16(v.z) * lo16(v.z) + hi16(v.z) * hi16(v.z) + lo16(v.w) * lo16(v.w) + hi16(v.w) * hi16(v.w); }
    rs = rsqrtf(ss / (float)K + 1e-6f); }
  for (int n0 = blockIdx.x * 8; n0 < N; n0 += gridDim.x * 8) {
    const int n = n0 + nl;
    if (n < N) {
      const bf16_t* wrow = W + (size_t)n * K; float acc = 0.f;
      for (int kc = 0; kc < kch; ++kc) { const uint4 av = *(const uint4*)(ar + kc * 16), wv = *(const uint4*)(wrow + kc * 8);
        acc += lo16(av.x) * lo16(wv.x) + hi16(av.x) * hi16(wv.x) + lo16(av.y) * lo16(wv.y) + hi16(av.y) * hi16(wv.y) + lo16(av.z) * lo16(wv.z) + hi16(av.z) * hi16(wv.z) + lo16(av.w) * lo16(wv.w) + hi16(av.w) * hi16(wv.w); }
      const float v = acc * rs;
      if (sub == 0) { if (n < 3072) p.R2[m * 3072 + n] = f2bf(v); else p.R1[((size_t)b * 1024 + n - 3072) * LP + pp] = f2bf(v); }
      else if (sub == 1) { if (n < 512) p.R3[m * 512 + n] = f2bf(v); else if (n < 768) p.R3[(size_t)MP * 512 + m * 256 + n - 512] = f2bf(v);
                           else if (n < 1792) p.R2[m * 1024 + n - 768] = f2bf(v); else p.R2[(size_t)MP * 2624 + m * 64 + n - 1792] = f2bf(v); }
      else if (sub == 2) p.R2[(size_t)MP * 1024 + m * 1536 + n] = f2bf(v);
      else if (sub == 3) { if (n < 1024) p.R0[m * 1024 + n] = f2bf(v); else p.R1[((size_t)b * 1024 + n - 1024) * LP + pp] = f2bf(v); }
      else p.hmeta[((size_t)(b * 64 + (lane & 15))) * DM + n] = ALPHA * hrow(p, b, pp)[n] + v;
    }
  }
  __syncthreads();
}
DI void kpe_rope_pass(const Params& p) {
  const bf16_t* raw = p.R2 + (size_t)MP * 2624; bf16_t* dst = p.R2 + (size_t)MP * 2560;
  const size_t gt = (size_t)blockIdx.x * NTHR + opaque_tid(), gs = (size_t)gridDim.x * NTHR;
  for (size_t i = gt; i < (size_t)NB * 4112 * 4; i += gs) { const int rr = (int)(i >> 2), f8 = (int)(i & 3) * 8; const int b = rr / 4112, pp = OFF + rr % 4112; const size_t m = (size_t)b * LP + pp;
    const uint4 lo = *(const uint4*)(raw + m * 64 + f8), hi = *(const uint4*)(raw + m * 64 + 32 + f8);
    const float* rp = p.rope + (size_t)pp * 64 + f8;
    const float4 c0 = *(const float4*)rp, c1 = *(const float4*)(rp + 4), s0 = *(const float4*)(rp + 32), s1 = *(const float4*)(rp + 36);
    const float cc[8] = {c0.x, c0.y, c0.z, c0.w, c1.x, c1.y, c1.z, c1.w}, sn[8] = {s0.x, s0.y, s0.z, s0.w, s1.x, s1.y, s1.z, s1.w};
    const unsigned lw[4] = {lo.x, lo.y, lo.z, lo.w}, hw[4] = {hi.x, hi.y, hi.z, hi.w};
    unsigned ol[4], oh[4];
#pragma unroll
    for (int q = 0; q < 4; ++q) {
      const float x1a = lo16(lw[q]), x1b = hi16(lw[q]), x2a = lo16(hw[q]), x2b = hi16(hw[q]);
      ol[q] = (unsigned)f2bf(x1a * cc[2 * q] - x2a * sn[2 * q]) | ((unsigned)f2bf(x1b * cc[2 * q + 1] - x2b * sn[2 * q + 1]) << 16);
      oh[q] = (unsigned)f2bf(x2a * cc[2 * q] + x1a * sn[2 * q]) | ((unsigned)f2bf(x2b * cc[2 * q + 1] + x1b * sn[2 * q + 1]) << 16);
    }
    *(uint4*)(dst + m * 64 + f8) = make_uint4(ol[0], ol[1], ol[2], ol[3]); *(uint4*)(dst + m * 64 + 32 + f8) = make_uint4(oh[0], oh[1], oh[2], oh[3]); }
}
DI void gemm_phase(const Params& p, int mode, int j, int layer, char* smem) {
  PG8_LAS unsigned char* lds = (PG8_LAS unsigned char*)smem;
  const int G = gridDim.x;
  const int c = __builtin_amdgcn_readfirstlane(((const int*)(smem + SM_SLOT + 256))[2]);
  if (mode == 0) {
    meta_gemm(p, 0, j, layer, smem);
#ifdef METAREP
    meta_gemm(p, 0, j, layer, smem);
#endif
    pg8::Gemm g{p.R0, p.W_evin + (size_t)j * 4096 * 1024, MP, 4096, 1024}; pg8::FrameOrder S; S.init(16, G, c); pg8::EpiMix<0> E{&p, 0};
    pg8::gemm_phase<pg8::EpiMix<0>, pg8::FrameOrder, true, true>(lds, g, S, E);
  } else if (mode == 1) {
    meta_gemm(p, 1, j, layer, smem);
    pg8::Gemm g{p.R0, p.W_odin + (size_t)j * 2048 * 1024, MP, 2048, 1024}; pg8::FrameOrder S; S.init(8, G, c); pg8::EpiMix<1> E{&p, 0};
    pg8::gemm_phase<pg8::EpiMix<1>, pg8::FrameOrder, true, true>(lds, g, S, E);
  } else if (mode == 2) {
    kpe_rope_pass(p);
    meta_gemm(p, 2, j, layer, smem); meta_gemm(p, 3, j, layer, smem);
    const bool lo = c < (G >> 1);
    const pg8::ListOrder Sq{lo ? 2 : 1, c, G, 6}, Skv{lo ? 1 : 3, lo ? c : (G >> 1) + (c - (G >> 1)) * 3, 1, 8};
    {
      const int t = opaque_tid();
      if (t < 256) {
        pg8::Unit u;
        for (int i = 0; Sq.next(i, u); ++i) { const size_t mrow = (size_t)(u.pm / 17) * LP + (u.pm % 17) * 256 + t; const float4* q = (const float4*)(p.rowss + mrow * 24); float a = 0.f;
          for (int k = 0; k < 4; ++k) { const float4 x = q[k]; a += (x.x + x.y) + (x.z + x.w); }
          p.rsarr[mrow * 2] = rsqrtf(a * (1.0f / 512.0f) + 1e-6f); }
        for (int i = 0; Skv.next(i, u); ++i) { const size_t mrow = (size_t)(u.pm / 17) * LP + (u.pm % 17) * 256 + t; const float4* q = (const float4*)(p.rowss + mrow * 24 + 16); float a = 0.f;
          for (int k = 0; k < 2; ++k) { const float4 x = q[k]; a += (x.x + x.y) + (x.z + x.w); }
          p.rsarr[mrow * 2 + 1] = rsqrtf(a * (1.0f / 256.0f) + 1e-6f); }
      }
      __threadfence_block(); __syncthreads();
    }
    { pg8::Gemm g{p.R3, p.W_oduq + (size_t)j * 1536 * 512, MP, 1536, 512}; pg8::EpiMix<2> E{&p, 0};
      pg8::gemm_phase<pg8::EpiMix<2>, pg8::ListOrder, true, true>(lds, g, Sq, E); }
    { pg8::Gemm g{p.R3 + (size_t)MP * 512, p.W_odukv + (size_t)j * 2048 * 256, MP, 2048, 256}; pg8::EpiMix<3> E{&p, 0};
      pg8::gemm_phase<pg8::EpiMix<3>, pg8::ListOrder, true, true>(lds, g, Skv, E); }
  } else {
    meta_gemm(p, 4, j, layer, smem);
    pg8::Gemm g{(layer & 1) ? p.R3 : p.R0, ((layer & 1) ? p.W_odout : p.W_evout) + (size_t)j * 1024 * 1024, MP, 1024, 1024}; pg8::FrameOrder S; S.init(4, G, c); pg8::EpiOutLn E{&p, layer == 0, layer};
    pg8::gemm_phase<pg8::EpiOutLn, pg8::FrameOrder, false, true>(lds, g, S, E);
  }
}

DI void norm_phase(const Params& p, int layer, char* smem) {
  const int tid = opaque_tid(), lane = tid & 63;
  const float* lg = p.ln_g + layer * 1024; const float* lb = p.ln_b + layer * 1024;
  const int gw = blockIdx.x * 8 + (tid >> 6), nw = gridDim.x * 8;
  for (int row = gw; row < NB * 4112; row += nw) {
    const int b = row / 4112, pp = OFF + row % 4112; const size_t m = (size_t)b * LP + pp;
    float* hr = hrow(p, b, pp);
    float4 z[4]; float s1 = 0.f;
#pragma unroll
    for (int i = 0; i < 4; ++i) { z[i] = *(const float4*)(hr + 256 * i + 4 * lane); s1 += (z[i].x + z[i].y) + (z[i].z + z[i].w); }
    const float mean = wave_sum(s1) * (1.0f / 1024.0f);
    float s2 = 0.f;
#pragma unroll
    for (int i = 0; i < 4; ++i) { const float a = z[i].x - mean, bq = z[i].y - mean, cq = z[i].z - mean, d = z[i].w - mean; s2 += (a * a + bq * bq) + (cq * cq + d * d); }
    const float rstd = rsqrtf(wave_sum(s2) * (1.0f / 1024.0f) + 1e-5f);
#pragma unroll
    for (int i = 0; i < 4; ++i) { const int n = 256 * i + 4 * lane; const float4 g = *(const float4*)(lg + n), bb = *(const float4*)(lb + n);
      float4 o; o.x = (z[i].x - mean) * rstd * g.x + bb.x; o.y = (z[i].y - mean) * rstd * g.y + bb.y; o.z = (z[i].z - mean) * rstd * g.z + bb.z; o.w = (z[i].w - mean) * rstd * g.w + bb.w;
      *(float4*)(hr + n) = o; *(uint2*)(p.R0 + m * 1024 + n) = pk4(o.x, o.y, o.z, o.w); }
  }
}

DI int next_item(unsigned* ctr, char* smem) {
  int* slot = (int*)(smem + SM_SLOT);
  __syncthreads();
  if (opaque_tid() == 0) *slot = (int)atomicAdd(ctr, 1u);
  __syncthreads();
  return *slot;
}
constexpr int M_KSZ = 25600, M_STAGE = 25600 + 17408;
DI void mla_item(const Params& p, int b, int head, int T, char* smem) {
  const int tid = opaque_tid(), w = tid >> 6, lane = tid & 63, r = lane & 31, hh = lane >> 5;
  const int q0 = T * 256, qw = q0 + 32 * w; const bool wact = qw >= 192; const int jq = qw >> 6; const int jtop = (q0 >> 6) + 3;
  const bf16_t* Q = p.R2 + (size_t)MP * 1024; const bf16_t* KP = p.R2 + (size_t)MP * 2560;
  const size_t mq = (size_t)b * LP + qw + r;
  bf16x8 qf[12];
#pragma unroll
  for (int s = 0; s < 12; ++s) qf[s] = *(const bf16x8*)(Q + mq * 1536 + 192 * head + 16 * s + 8 * hh);
  {
    const float* rp = p.rope + (size_t)(qw + r) * 64 + 8 * hh;
#pragma unroll
    for (int s = 8; s < 10; ++s) {
      const float4 ca = *(const float4*)(rp + 16 * (s - 8)), cb = *(const float4*)(rp + 16 * (s - 8) + 4), sa = *(const float4*)(rp + 32 + 16 * (s - 8)), sb = *(const float4*)(rp + 32 + 16 * (s - 8) + 4);
      const float cc[8] = {ca.x, ca.y, ca.z, ca.w, cb.x, cb.y, cb.z, cb.w}, sn[8] = {sa.x, sa.y, sa.z, sa.w, sb.x, sb.y, sb.z, sb.w};
      float y1[8], y2[8];
#pragma unroll
      for (int jj = 0; jj < 8; ++jj) { const float x1 = bf2f((bf16_t)qf[s][jj]), x2 = bf2f((bf16_t)qf[s + 2][jj]); y1[jj] = x1 * cc[jj] - x2 * sn[jj]; y2[jj] = x2 * cc[jj] + x1 * sn[jj]; }
      uint4 u1, u2; u1.x = pk2(y1[0], y1[1]); u1.y = pk2(y1[2], y1[3]); u1.z = pk2(y1[4], y1[5]); u1.w = pk2(y1[6], y1[7]);
      u2.x = pk2(y2[0], y2[1]); u2.y = pk2(y2[2], y2[3]); u2.z = pk2(y2[4], y2[5]); u2.w = pk2(y2[6], y2[7]);
      qf[s] = __builtin_bit_cast(bf16x8, u1); qf[s + 2] = __builtin_bit_cast(bf16x8, u2);
    }
  }
  f32x16 O[4];
#pragma unroll
  for (int d = 0; d < 4; ++d)
#pragma unroll
    for (int e = 0; e < 16; ++e) O[d][e] = 0.f;
  float mrun = -INFINITY, lrun = 0.f;
  uint4 k0, k1, k2, v0, v1;
  const int kr = tid >> 3, kc = tid & 7;
  const int vd = tid >> 3, vkc = tid & 7;
  auto ldv = [&](int jt, int i) -> uint4 { return *(const uint4*)(p.R1 + ((size_t)b * 1024 + 128 * head + vd + 64 * i) * LP + 64 * jt + vkc * 8); };
  auto stv = [&](char* sb, int i, uint4 v) { char* vp = sb + M_KSZ + (vd + 64 * i) * 136 + vkc * 16; *(uint2*)vp = make_uint2(v.x, v.y); *(uint2*)(vp + 8) = make_uint2(v.z, v.w); };
#define A_LOAD(jt) { const size_t mk = (size_t)b * LP + 64 * (jt) + kr; const bf16_t* kn = p.R0 + mk * 1024 + 128 * head + kc * 8; \
                     k0 = *(const uint4*)kn; k1 = *(const uint4*)(kn + 64); k2 = *(const uint4*)(KP + mk * 64 + kc * 8); v0 = ldv(jt, 0); v1 = ldv(jt, 1); }
#define A_STORE(st) { char* sb = smem + (st) * M_STAGE; char* kp_ = sb + kr * 400 + kc * 16; *(uint4*)kp_ = k0; *(uint4*)(kp_ + 128) = k1; *(uint4*)(kp_ + 256) = k2; stv(sb, 0, v0); stv(sb, 1, v1); }
  A_LOAD(3); A_STORE(0);
  __syncthreads();
  for (int jt = 3; jt <= jtop; ++jt) {
    const int cur = (jt - 3) & 1;
    const bool act = wact && jt <= jq;
    f32x16 st[2];
    if (act) {
      const char* kb_ = smem + cur * M_STAGE + r * 400 + hh * 16;
#pragma unroll
      for (int e = 0; e < 16; ++e) { st[0][e] = 0.f; st[1][e] = 0.f; }
      {
        bf16x8 f[2][2][2];
#pragma unroll
        for (int i = 0; i < 2; ++i) { f[0][0][i] = ld_frag(kb_ + i * 32); f[0][1][i] = ld_frag(kb_ + 32 * 400 + i * 32); }
#pragma unroll
        for (int bt = 0; bt < 6; ++bt) {
          if (bt < 5) {
#pragma unroll
            for (int i = 0; i < 2; ++i) { f[(bt + 1) & 1][0][i] = ld_frag(kb_ + (2 * bt + 2 + i) * 32); f[(bt + 1) & 1][1][i] = ld_frag(kb_ + 32 * 400 + (2 * bt + 2 + i) * 32); }
          }
          __builtin_amdgcn_sched_barrier(0);
#pragma unroll
          for (int i = 0; i < 2; ++i) { st[0] = MFMA32(f[bt & 1][0][i], qf[2 * bt + i], st[0]); st[1] = MFMA32(f[bt & 1][1][i], qf[2 * bt + i], st[1]); }
          __builtin_amdgcn_sched_barrier(0);
        }
      }
    }
    if (jt < jtop) { A_LOAD(jt + 1); }
    if (act) {
      if (jt == 3) {
#pragma unroll
        for (int e = 0; e < 16; ++e) st[0][e] = -INFINITY;
#pragma unroll
        for (int e = 0; e < 8; ++e) st[1][e] = -INFINITY;
      }
      float mx = st[0][0];
#pragma unroll
      for (int e = 1; e < 16; ++e) mx = fmaxf(mx, st[0][e]);
#pragma unroll
      for (int e = 0; e < 16; ++e) mx = fmaxf(mx, st[1][e]);
      mx = x32_max(mx);
      if (!__builtin_expect(__all(mx - mrun <= 6.0f), 1)) {
        const float mnew = fmaxf(mrun, mx); const float alpha = ex2(mrun - mnew); mrun = mnew; lrun *= alpha;
#pragma unroll
        for (int d = 0; d < 4; ++d)
#pragma unroll
          for (int e = 0; e < 16; ++e) O[d][e] *= alpha;
      }
      float rsum = 0.f;
#pragma unroll
      for (int kb = 0; kb < 2; ++kb)
#pragma unroll
        for (int e = 0; e < 16; ++e) { const float pv = ex2(st[kb][e] - mrun); st[kb][e] = pv; rsum += pv; }
      lrun += rsum;
      const char* vb_ = smem + cur * M_STAGE + M_KSZ + r * 136 + hh * 8;
#pragma unroll
      for (int kb = 0; kb < 2; ++kb)
#pragma unroll
        for (int s2 = 0; s2 < 2; ++s2) { const bf16x8 pf = pack_step(st[kb], s2);
#pragma unroll
          for (int d = 0; d < 4; ++d) O[d] = MFMA32(ld_vfrag(vb_ + d * 32 * 136 + (32 * kb + 16 * s2) * 2), pf, O[d]); }
    }
    if (jt < jtop) { A_STORE(cur ^ 1); }
    __syncthreads();
  }
#undef A_LOAD
#undef A_STORE
  if (wact) {
    const float l = x32_sum(lrun); const float inv = 1.0f / l;
    const bf16_t* G = p.R2 + mq * 1024 + 128 * head; bf16_t* Yp = p.R3 + mq * 1024 + 128 * head;
#pragma unroll
    for (int d = 0; d < 4; ++d)
#pragma unroll
      for (int gp = 0; gp < 2; ++gp) { uint2 ab[2];
#pragma unroll
        for (int k = 0; k < 2; ++k) { const int g = 2 * gp + k; const int dd = 32 * d + 8 * g + 4 * hh; const uint2 gv = *(const uint2*)(G + dd);
          ab[k] = pk4(O[d][4 * g] * inv * silu_f(lo16(gv.x)), O[d][4 * g + 1] * inv * silu_f(hi16(gv.x)), O[d][4 * g + 2] * inv * silu_f(lo16(gv.y)), O[d][4 * g + 3] * inv * silu_f(hi16(gv.y))); }
        store_pair16(Yp, 32 * d + 16 * gp, hh, ab[0], ab[1]); }
  }
}
DI void mla_phase(const Params& p, int layer, char* smem) {
  for (;;) { const int id = next_item(p.ctr + layer, smem); if (id >= 17 * 32) break;
    const int T = 16 - id / 32, u = id % 32; mla_item(p, u >> 3, u & 7, T, smem); }
}
constexpr int D_KSZ = 17408, D_STAGE = 34816;
DI void diff_item(const Params& p, int j, int b, int head, int t, char* smem) {
  const int tid = opaque_tid(), w = tid >> 6, lane = tid & 63, r = lane & 31, hh = lane >> 5, map = w >> 2;
  const int q0 = t * 128, qw = q0 + 32 * (w & 3); const bool wact = qw >= 192; const int jq = qw >> 6; const int jtop = (q0 >> 6) + 1;
  const size_t mq = (size_t)b * LP + qw + r;
  bf16x8 qf[4];
#pragma unroll
  for (int s = 0; s < 4; ++s) qf[s] = *(const bf16x8*)(p.R2 + mq * 3072 + 128 * head + 64 * map + 16 * s + 8 * hh);
  f32x16 O[4];
#pragma unroll
  for (int d = 0; d < 4; ++d)
#pragma unroll
    for (int e = 0; e < 16; ++e) O[d][e] = 0.f;
  float mrun = -INFINITY, lrun = 0.f;
  const float sl2 = ex2(-2.0f * (float)(head + 1)) * LOG2E;
  uint4 k0, k1, v0, v1;
  const int krow = tid >> 4, kkc = tid & 15, vd = tid >> 3, vkc = tid & 7;
  auto ldk = [&](int jt, int i) -> uint4 { return *(const uint4*)(p.R2 + ((size_t)b * LP + 64 * jt + krow + 32 * i) * 3072 + 512 + 128 * head + kkc * 8); };
  auto ldv = [&](int jt, int i) -> uint4 { return *(const uint4*)(p.R1 + ((size_t)b * 1024 + 128 * head + vd + 64 * i) * LP + 64 * jt + vkc * 8); };
  auto stv = [&](char* sb, int i, uint4 v) { char* vp = sb + D_KSZ + (vd + 64 * i) * 136 + vkc * 16; *(uint2*)vp = make_uint2(v.x, v.y); *(uint2*)(vp + 8) = make_uint2(v.z, v.w); };
#define A_LOAD(jt) { k0 = ldk(jt, 0); k1 = ldk(jt, 1); v0 = ldv(jt, 0); v1 = ldv(jt, 1); }
#define A_STORE(st) { char* sb = smem + (st) * D_STAGE; *(uint4*)(sb + krow * 272 + kkc * 16) = k0; *(uint4*)(sb + (krow + 32) * 272 + kkc * 16) = k1; stv(sb, 0, v0); stv(sb, 1, v1); }
  const bool skp = head < 2;
  float bq = 0.f;
  if (skp) {
    float* red = (float*)(smem + SM_SLOT + 128);
    float m0 = 0.f, m1 = 0.f;
    for (int row = 256 + tid; row < q0 + 128; row += NTHR) { const float4 v = *(const float4*)(p.rowss + ((size_t)b * LP + row) * 24 + 4 * head); m0 = fmaxf(m0, v.x + v.y); m1 = fmaxf(m1, v.z + v.w); }
    m0 = wave_max(m0); m1 = wave_max(m1);
    if (lane == 0) { red[w] = m0; red[8 + w] = m1; }
    __syncthreads();
    float km = 0.f;
#pragma unroll
    for (int i = 0; i < 8; ++i) km = fmaxf(km, red[8 * map + i]);
    float qn = 0.f;
#pragma unroll
    for (int s_ = 0; s_ < 4; ++s_)
#pragma unroll
      for (int jj = 0; jj < 8; ++jj) { const float x = bf2f((bf16_t)qf[s_][jj]); qn += x * x; }
    qn = x32_sum(qn);
    bq = sqrtf(qn * km) * 1.01f + 0.01f;
  }
  bool wdone = false;
  int jt = jtop, cur = 0, step = 0;
  A_LOAD(jtop); A_STORE(0);
  __syncthreads();
  for (;;) {
    const int nj = jt - 1;
    if (nj >= 3) { A_LOAD(nj); }
    if (wact && jt <= jq && !(wdone && jt > 3)) {
      const char* kb_ = smem + cur * D_STAGE + r * 272 + 128 * map + hh * 16;
      f32x16 st[2];
      {
        bf16x8 f0[4], f1[4];
#pragma unroll
        for (int i = 0; i < 4; ++i) { f0[i] = ld_frag(kb_ + i * 32); f1[i] = ld_frag(kb_ + 32 * 272 + i * 32); }
        __builtin_amdgcn_sched_barrier(0);
#pragma unroll
        for (int e = 0; e < 16; ++e) { st[0][e] = 0.f; st[1][e] = 0.f; }
#pragma unroll
        for (int i = 0; i < 4; ++i) { st[0] = MFMA32(f0[i], qf[i], st[0]); st[1] = MFMA32(f1[i], qf[i], st[1]); }
      }
#pragma unroll
      for (int kb = 0; kb < 2; ++kb) {
        const float dq = (float)(qw + r - 64 * jt - 32 * kb - 4 * hh);
#pragma unroll
        for (int e = 0; e < 16; ++e) st[kb][e] -= sl2 * fabsf(dq - (float)((e & 3) + 8 * (e >> 2)));
      }
      if (jt == 3) {
#pragma unroll
        for (int e = 0; e < 16; ++e) st[0][e] = -INFINITY;
#pragma unroll
        for (int e = 0; e < 8; ++e) st[1][e] = -INFINITY;
      }
      float mx = st[0][0];
#pragma unroll
      for (int e = 1; e < 16; ++e) mx = fmaxf(mx, st[0][e]);
#pragma unroll
      for (int e = 0; e < 16; ++e) mx = fmaxf(mx, st[1][e]);
      mx = x32_max(mx);
      if (!__builtin_expect(__all(mx - mrun <= 6.0f), 1)) {
        const float mnew = fmaxf(mrun, mx); const float alpha = ex2(mrun - mnew); mrun = mnew; lrun *= alpha;
#pragma unroll
        for (int d = 0; d < 4; ++d)
#pragma unroll
          for (int e = 0; e < 16; ++e) O[d][e] *= alpha;
      }
      float rsum = 0.f;
#pragma unroll
      for (int kb = 0; kb < 2; ++kb)
#pragma unroll
        for (int e = 0; e < 16; ++e) { const float pv = ex2(st[kb][e] - mrun); st[kb][e] = pv; rsum += pv; }
      lrun += rsum;
      const char* vb_ = smem + cur * D_STAGE + D_KSZ + r * 136 + hh * 8;
#pragma unroll
      for (int kb = 0; kb < 2; ++kb)
#pragma unroll
        for (int s2 = 0; s2 < 2; ++s2) { const bf16x8 pf = pack_step(st[kb], s2);
#pragma unroll
          for (int d = 0; d < 4; ++d) O[d] = MFMA32(ld_vfrag(vb_ + d * 32 * 136 + (32 * kb + 16 * s2) * 2), pf, O[d]); }
      if (skp) wdone = !__any(bq - sl2 * (float)(qw + r - 64 * nj - 63) - mrun > -150.0f);
    }
    if (nj >= 3) { A_STORE(cur ^ 1); }
    bool alld = false;
    if (skp && nj > 3) {
      int* fl = (int*)(smem + SM_SLOT + 64) + (step & 1) * 8;
      if (lane == 0) fl[w] = ((!wact) || (jt <= jq && wdone)) ? 1 : 0;
      __syncthreads();
      const int4 f0 = *(const int4*)fl, f1 = *(const int4*)(fl + 4);
      alld = (f0.x & f0.y & f0.z & f0.w & f1.x & f1.y & f1.z & f1.w) != 0;
    } else __syncthreads();
    if (nj < 3) break;
    if (alld) { A_LOAD(3); A_STORE(cur); __syncthreads(); jt = 3; }
    else { jt = nj; cur ^= 1; }
    ++step;
  }
#undef A_LOAD
#undef A_STORE
  const float l = x32_sum(lrun); const float inv = wact ? 1.0f / l : 0.f;
  float* ex = (float*)smem + (size_t)(w & 3) * 4096 + lane;
  if (map == 1) {
#pragma unroll
    for (int d = 0; d < 4; ++d)
#pragma unroll
      for (int e = 0; e < 16; ++e) ex[(d * 16 + e) * 64] = O[d][e] * inv;
  }
  __syncthreads();
  if (map == 0 && wact) {
    const float lam = p.lam[2 * j], om = 1.0f - p.lam[2 * j + 1];
    float ss = 0.f;
#pragma unroll
    for (int d = 0; d < 4; ++d)
#pragma unroll
      for (int e = 0; e < 16; ++e) { const float o = O[d][e] * inv - lam * ex[(d * 16 + e) * 64]; O[d][e] = o; ss += o * o; }
    ss = x32_sum(ss);
    const float rr = rsqrtf(ss * (1.0f / 128.0f) + 1e-6f) * om;
    const bf16_t* G = p.R2 + mq * 3072 + 1024 + 128 * head; bf16_t* Yp = p.R0 + mq * 1024 + 128 * head; const float* sg = p.subln + j * 128;
#pragma unroll
    for (int d = 0; d < 4; ++d)
#pragma unroll
      for (int gp = 0; gp < 2; ++gp) { uint2 ab[2];
#pragma unroll
        for (int k = 0; k < 2; ++k) { const int g = 2 * gp + k; const int dd = 32 * d + 8 * g + 4 * hh; const uint2 gv = *(const uint2*)(G + dd); const float4 s4 = *(const float4*)(sg + dd);
          ab[k] = pk4(O[d][4 * g] * rr * s4.x * silu_f(lo16(gv.x)), O[d][4 * g + 1] * rr * s4.y * silu_f(hi16(gv.x)), O[d][4 * g + 2] * rr * s4.z * silu_f(lo16(gv.y)), O[d][4 * g + 3] * rr * s4.w * silu_f(hi16(gv.y))); }
        store_pair16(Yp, 32 * d + 16 * gp, hh, ab[0], ab[1]); }
  }
}
constexpr int S_KSZ = 9216, S_STAGE = 9216 + 8704;
DI void sb_item(const Params& p, int b, int hg, int jq, char* smem) {
  const int tid = opaque_tid(), w = tid >> 6, lane = tid & 63, r = lane & 31, hh = lane >> 5;
  const int head = 4 * hg + (w >> 1); const int qw = 64 * jq + 32 * (w & 1); const bool wact = true; const int jtop = jq;
  const size_t mq = (size_t)b * LP + qw + r; const int qpos = qw + r;
  bf16x8 qf[4];
#pragma unroll
  for (int s = 0; s < 4; ++s) qf[s] = *(const bf16x8*)(p.R2 + mq * 3072 + 1536 + 64 * head + 16 * s + 8 * hh);
  f32x16 O[2];
#pragma unroll
  for (int d = 0; d < 2; ++d)
#pragma unroll
    for (int e = 0; e < 16; ++e) O[d][e] = 0.f;
  float carry = 0.f;
  uint4 k0, k1, k2, k3, v0, v1, v2, v3;
  const int krow = tid >> 3, kkc = tid & 7;
  auto ldk = [&](int jt, int i) -> uint4 { return *(const uint4*)(p.R2 + ((size_t)b * LP + 64 * jt + krow) * 3072 + 2048 + 64 * (4 * hg + i) + kkc * 8); };
  auto ldv = [&](int jt, int i) -> uint4 { return *(const uint4*)(p.R1 + ((size_t)b * 1024 + 512 + 64 * (4 * hg + i) + krow) * LP + 64 * jt + kkc * 8); };
  auto sto = [&](int i, uint4 kk, uint4 vv) { char* sb = smem + i * S_STAGE; *(uint4*)(sb + krow * 144 + kkc * 16) = kk;
    char* vp = sb + S_KSZ + krow * 136 + kkc * 16; *(uint2*)vp = make_uint2(vv.x, vv.y); *(uint2*)(vp + 8) = make_uint2(vv.z, vv.w); };
#define A_LOAD(jt) { k0 = ldk(jt, 0); k1 = ldk(jt, 1); k2 = ldk(jt, 2); k3 = ldk(jt, 3); v0 = ldv(jt, 0); v1 = ldv(jt, 1); v2 = ldv(jt, 2); v3 = ldv(jt, 3); }
#define A_STORE() { sto(0, k0, v0); sto(1, k1, v1); sto(2, k2, v2); sto(3, k3, v3); }
  A_LOAD(jtop); A_STORE();
  __syncthreads();
  bool wdone = false;
  for (int jt = jtop; jt >= 3; --jt) {
    const int cur = w >> 1;
    if (jt > 3) { A_LOAD(jt - 1); }
    if (!wdone) {
      const char* kb_ = smem + cur * S_STAGE + r * 144 + hh * 16;
      f32x16 st[2];
#pragma unroll
      for (int kb = 0; kb < 2; ++kb) {
#pragma unroll
        for (int e = 0; e < 16; ++e) st[kb][e] = 0.f;
#pragma unroll
        for (int s = 0; s < 4; ++s) st[kb] = MFMA32(ld_frag(kb_ + kb * 32 * 144 + s * 32), qf[s], st[kb]);
      }
      const bool edge = (jt == jq) || (jt == 3);
      float running = carry;
#pragma unroll
      for (int kb = 1; kb >= 0; --kb) {
        float t_[16];
#pragma unroll
        for (int g = 3; g >= 0; --g) {
          float sfx = 0.f;
#pragma unroll
          for (int e = 3; e >= 0; --e) { const int i = 4 * g + e; const float z = st[kb][i];
            float ls = -(fmaxf(z, 0.f) + lg2(1.0f + ex2(-fabsf(z))));
            if (edge) { const int kpos = 64 * jt + 32 * kb + 8 * g + 4 * hh + e; if (!(kpos < qpos && kpos >= OFF)) ls = 0.f; }
            sfx += ls; t_[i] = sfx; }
          const auto tt = __builtin_amdgcn_permlane32_swap(__float_as_uint(sfx), __float_as_uint(sfx), false, false);
          const float T0 = __uint_as_float(tt[0]), T1 = __uint_as_float(tt[1]);
          const float base = hh ? running : running + T1;
          running += T1 + T0;
#pragma unroll
          for (int e = 0; e < 4; ++e) { const int i = 4 * g + e; float a = ex2(st[kb][i] + base + t_[i]);
            if (edge) { const int kpos = 64 * jt + 32 * kb + 8 * g + 4 * hh + e; if (!(kpos < qpos && kpos >= OFF)) a = 0.f; }
            st[kb][i] = a; }
        }
      }
      carry = running;
      wdone = !__any(carry > -150.0f);
      const char* vb_ = smem + cur * S_STAGE + S_KSZ + r * 136 + hh * 8;
#pragma unroll
      for (int kb = 0; kb < 2; ++kb)
#pragma unroll
        for (int s2 = 0; s2 < 2; ++s2) { const bf16x8 pf = pack_step(st[kb], s2);
#pragma unroll
          for (int d = 0; d < 2; ++d) O[d] = MFMA32(ld_vfrag(vb_ + d * 32 * 136 + (32 * kb + 16 * s2) * 2), pf, O[d]); }
    }
    {
      int* fl = (int*)(smem + SM_SLOT + 64);
      if (lane == 0) fl[w] = wdone ? 1 : 0;
      __syncthreads();
      const int4 f0 = *(const int4*)fl, f1 = *(const int4*)(fl + 4);
      if (jt == 3 || (f0.x & f0.y & f0.z & f0.w & f1.x & f1.y & f1.z & f1.w) != 0) break;
    }
    A_STORE();
    __syncthreads();
  }
#undef A_LOAD
#undef A_STORE
  if (wact) {
    const bf16_t* G = p.R2 + mq * 3072 + 2560 + 64 * head; bf16_t* Yp = p.R0 + mq * 1024 + 512 + 64 * head;
#pragma unroll
    for (int d = 0; d < 2; ++d)
#pragma unroll
      for (int gp = 0; gp < 2; ++gp) { uint2 ab[2];
#pragma unroll
        for (int k = 0; k < 2; ++k) { const int g = 2 * gp + k; const int dd = 32 * d + 8 * g + 4 * hh; const uint2 gv = *(const uint2*)(G + dd);
          ab[k] = pk4(O[d][4 * g] * silu_f(lo16(gv.x)), O[d][4 * g + 1] * silu_f(hi16(gv.x)), O[d][4 * g + 2] * silu_f(lo16(gv.y)), O[d][4 * g + 3] * silu_f(hi16(gv.y))); }
        store_pair16(Yp, 32 * d + 16 * gp, hh, ab[0], ab[1]); }
  }
}
DI void evattn_phase(const Params& p, int layer, int which, char* smem) {
  const int j = layer >> 1;
  for (;;) { const int id = next_item(p.ctr + layer + 8 * which, smem); if (id >= 17 * 64) break;
    if (id < 17 * 32) { const int T = 16 - id / 32, v = id % 32; const int head = 3 - (v >> 3), b = (v & 7) >> 1, t = 2 * T + 1 - (v & 1);
      if (t >= 1 && (which & 1)) diff_item(p, j, b, head, t, smem); }
    else { const int i2 = id - 17 * 32; const int T = 16 - i2 / 32, u = i2 % 32; const int jq = 4 * T + ((u & 7) >> 1);
      if ((which & 2) && jq >= 3) sb_item(p, u >> 3, u & 1, jq, smem); }
  }
}

#define XB_TMO      128
#define XB_XCNT(j)  (256  + 64 * (j))
#define XB_XSUB(j)  (1280 + 64 * (j))
#define XB_XGEN(j)  (2304 + 64 * (j))
#define XB_TOP      3328
#define XB_TOPGEN   3392
#define XCD_BAR_WORDS 3456
#define XB_SPIN_CAP (1u << 18)
#define LAS __attribute__((address_space(3)))

__device__ __forceinline__ unsigned xb_ld(unsigned* p)              { return __hip_atomic_load(p, __ATOMIC_RELAXED, __HIP_MEMORY_SCOPE_AGENT); }
__device__ __forceinline__ unsigned xb_add(unsigned* p, unsigned v) { return __hip_atomic_fetch_add(p, v, __ATOMIC_RELAXED, __HIP_MEMORY_SCOPE_AGENT); }
__device__ __forceinline__ unsigned xb_xcc_id() { return (unsigned)__builtin_amdgcn_s_getreg((3 << 11) | 20) & 0xFu; }
#define XB_SPIN(cond, bar) do { unsigned _sp = 0; while (cond) { __builtin_amdgcn_s_sleep(1); \
    if ((++_sp & 255u) == 0u) { if (xb_ld(&(bar)[XB_TMO])) break; if (_sp > XB_SPIN_CAP) { atomicAdd(&(bar)[XB_TMO], 1u); break; } } } } while (0)

struct XcdBarrier {
    unsigned* bar; unsigned x;
    volatile LAS unsigned* st;
};

__device__ __forceinline__ XcdBarrier xcd_barrier_post(unsigned* bar, volatile LAS unsigned* st) {
    XcdBarrier b; b.bar = bar; b.x = xb_xcc_id(); b.st = st;
    if (threadIdx.x == 0) (void)xb_add(&bar[XB_XCNT(b.x)], 1u);
    return b;
}
__device__ __forceinline__ void xcd_barrier_complete(unsigned* bar, unsigned x, unsigned& nloc, unsigned& nx) {
    const unsigned G = gridDim.x * gridDim.y * gridDim.z;
    unsigned sum, cnt, mine, sp = 0u;
    for (;;) {
        sum = 0u; cnt = 0u; mine = 0u;
#pragma unroll
        for (unsigned j = 0; j < 16; ++j) { const unsigned c = xb_ld(&bar[XB_XCNT(j)]); sum += c; cnt += (c > 0u) ? 1u : 0u; mine = (j == x) ? c : mine; }
        if (sum == G) break;
        __builtin_amdgcn_s_sleep(1);
        if ((++sp & 255u) == 0u) { if (xb_ld(&bar[XB_TMO])) break; if (sp > XB_SPIN_CAP) { atomicAdd(&bar[XB_TMO], 1u); break; } }
    }
    nloc = mine > 0u ? mine : 1u; nx = cnt > 0u ? cnt : 1u;
}

__device__ __forceinline__ void xcd_barrier(const XcdBarrier& b) {
    asm volatile("s_waitcnt vmcnt(0)" ::: "memory");
    __syncthreads();
    if (threadIdx.x == 0) {
        unsigned* bar = b.bar;
        __builtin_amdgcn_s_waitcnt(0);
        unsigned nloc = b.st[0], nx = b.st[1];
        if (nloc == 0u) { xcd_barrier_complete(bar, b.x, nloc, nx); b.st[0] = nloc; b.st[1] = nx; }
        const unsigned old = xb_add(&bar[XB_XSUB(b.x)], 1u);
        const unsigned gen = old / nloc;
        if (old + 1u == (gen + 1u) * nloc) {
            __builtin_amdgcn_fence(__ATOMIC_RELEASE, "agent");
            asm volatile("s_waitcnt vmcnt(0)" ::: "memory");
            const unsigned og = xb_add(&bar[XB_TOP], 1u);
            const unsigned tg = og / nx;
            if (og + 1u == (tg + 1u) * nx) xb_add(&bar[XB_TOPGEN], 1u);
            else XB_SPIN(xb_ld(&bar[XB_TOPGEN]) == tg, bar);
            __builtin_amdgcn_fence(__ATOMIC_ACQUIRE, "agent");
            xb_add(&bar[XB_XGEN(b.x)], 1u);
            asm volatile("s_waitcnt vmcnt(0)" ::: "memory");
        } else {
            XB_SPIN(xb_ld(&bar[XB_XGEN(b.x)]) == gen, bar);
            __builtin_amdgcn_fence(__ATOMIC_ACQUIRE, "agent");
            asm volatile("s_waitcnt vmcnt(0)" ::: "memory");
        }
    }
    __syncthreads();
}


constexpr int NPHASE = 21;
DI bool phase_noop(int ph) { if (ph == 0) return false; const int layer = (ph - 1) / 5, s = (ph - 1) % 5; return s == 4 || (s == 1 && !(layer & 1)); }
DI void run_phase(const Params& p, int ph, int which, char* smem) {
  if (ph == 0) {
    const int tid = opaque_tid();
    conv_all(p, (float*)smem, tid);
    prep_elem(p, (size_t)blockIdx.x * NTHR + tid, (size_t)gridDim.x * NTHR);
    return;
  }
  const int layer = (ph - 1) / 5, s = (ph - 1) % 5, j = layer >> 1; const bool odd = layer & 1;
  if (s == 0) gemm_phase(p, odd ? 1 : 0, j, layer, smem);
  else if (s == 1) { if (odd) gemm_phase(p, 2, j, layer, smem); }
  else if (s == 2) { if (odd) mla_phase(p, layer, smem); else evattn_phase(p, layer, which, smem); }
  else if (s == 3) gemm_phase(p, 3, j, layer, smem);
}
#ifndef REPWHICH
#define REPWHICH 3
#endif
#ifndef REPMASK
#define REPMASK 0
#endif
__global__ void __launch_bounds__(NTHR) k_mega(Params p, int ph0, int ph1, int which) {
  __shared__ __attribute__((aligned(1024))) char smem[SMEM_BYTES];
  uint4& xb_words = *(uint4*)(smem + SM_SLOT + 256);
  const bool mega = ph1 - ph0 > 1;
  if (threadIdx.x == 0) {
    unsigned slot = 0u;
    if (mega) slot = __hip_atomic_fetch_add(&p.bar[xb_xcc_id()], 1u, __ATOMIC_RELAXED, __HIP_MEMORY_SCOPE_AGENT);
    xb_words = make_uint4(0u, 0u, blockIdx.x, slot);
  }
  __syncthreads();
  if (mega) (void)xcd_barrier_post(p.bar, (volatile LAS unsigned*)&xb_words);
#define XBAR() { XcdBarrier xb_; xb_.bar = p.bar; xb_.x = xb_xcc_id(); xb_.st = (volatile LAS unsigned*)&xb_words; xcd_barrier(xb_); }
  int nsync = 0;
  if (ph0 == 0) {
    run_phase(p, 0, which, smem);
    if (((REPMASK >> 11) & 1)) { cg::this_grid().sync(); run_phase(p, 0, which, smem); }
    if (ph1 > 1) { if (which < 0) cg::this_grid().sync();
                   XBAR(); }
    ph0 = 1;
  }
  if (mega) {
    if (threadIdx.x == 0) {
      const unsigned slot = xb_words.w, x = xb_xcc_id(); unsigned rank = 0u;
      for (unsigned k = 0; k < 16; ++k) { const unsigned cnt = __hip_atomic_load(&p.bar[k], __ATOMIC_RELAXED, __HIP_MEMORY_SCOPE_AGENT); rank += cnt < slot ? cnt : slot; if (k < x && cnt > slot) ++rank; }
      xb_words.z = rank;
    }
    __syncthreads();
  }
  for (int ph = ph0; ph < ph1; ++ph) {
    if (phase_noop(ph)) continue;
    if (nsync > 0) XBAR();
    ++nsync;
    run_phase(p, ph, which, smem);
    if (REPMASK && ph > 0) {
      const int layer = (ph - 1) / 5, s = (ph - 1) % 5;
      if ((REPMASK >> (s + 5 * (layer & 1))) & 1) { XBAR(); p.ctr += 32; run_phase(p, ph, REPWHICH, smem); p.ctr -= 32; }
      if (((REPMASK >> 10) & 1) && ph == 1) { for (int i = 0; i < 20; ++i) XBAR(); }
    }
  }
}

extern "C" void kernel_launch(void* const* d_in, const int* in_sizes, int n_in, void* d_out, int out_size, void* d_ws, size_t ws_size, hipStream_t stream) {
  Params p{};
  p.x = (const float*)d_in[0]; p.meta = (const float*)d_in[1]; p.ln_g = (const float*)d_in[2]; p.ln_b = (const float*)d_in[3];
  p.ev_w_in = (const float*)d_in[4]; p.ev_w_out = (const float*)d_in[5]; p.lq1 = (const float*)d_in[6]; p.lk1 = (const float*)d_in[7];
  p.lq2 = (const float*)d_in[8]; p.lk2 = (const float*)d_in[9]; p.subln = (const float*)d_in[10]; p.od_w_in = (const float*)d_in[11];
  p.od_qn = (const float*)d_in[12]; p.od_w_uq = (const float*)d_in[13]; p.od_kvn = (const float*)d_in[14]; p.od_w_ukv = (const float*)d_in[15];
  p.od_w_out = (const float*)d_in[16];
  p.out = (float*)d_out;
  char* w = (char*)d_ws; size_t o = 0;
  auto take = [&](size_t bytes) { char* r = w + o; o += (bytes + 255) & ~(size_t)255; return r; };
  p.W_evin = (bf16_t*)take((size_t)2 * 4096 * 1024 * 2); p.W_evout = (bf16_t*)take((size_t)2 * 1024 * 1024 * 2);
  p.W_odin = (bf16_t*)take((size_t)2 * 2048 * 1024 * 2); p.W_oduq = (bf16_t*)take((size_t)2 * 1536 * 512 * 2);
  p.W_odukv = (bf16_t*)take((size_t)2 * 2048 * 256 * 2); p.W_odout = (bf16_t*)take((size_t)2 * 1024 * 1024 * 2);
  p.R0 = (bf16_t*)take((size_t)MP * 1024 * 2); p.R1 = (bf16_t*)take((size_t)MP * 1024 * 2);
  p.R2 = (bf16_t*)take((size_t)MP * 3072 * 2); p.R3 = (bf16_t*)take((size_t)MP * 1024 * 2);
  p.hmeta = (float*)take((size_t)NB * 64 * DM * 4); p.rope = (float*)take((size_t)LP * 64 * 4);
  p.lam = (float*)take(256); p.ctr = (unsigned*)take(512); p.rowss = (float*)take((size_t)MP * 24 * 4); p.rsarr = (float*)take((size_t)MP * 2 * 4); p.bar = (unsigned*)take((size_t)(XCD_BAR_WORDS + 4 * 68 * 16) * 4); p.pcnt = p.bar + XCD_BAR_WORDS; p.xch = (float*)take((size_t)68 * 1024 * 8);
  if (o > ws_size) { fprintf(stderr, "workspace too small: need %zu have %zu\n", o, ws_size); return; }

#ifndef MODE_MEGA
#define MODE_MEGA 1
#endif
#ifndef FASTMASK
#define FASTMASK 127
#endif
  hipMemsetAsync(p.bar, 0, (size_t)(XCD_BAR_WORDS + 4 * 68 * 16) * 4, stream);
#if MODE_MEGA
  static int grid_blocks = 0;
  if (!grid_blocks) {
    int dev = 0, cus = 0, per_cu = 0;
    hipGetDevice(&dev);
    hipDeviceGetAttribute(&cus, hipDeviceAttributeMultiprocessorCount, dev);
    hipOccupancyMaxActiveBlocksPerMultiprocessor(&per_cu, k_mega, NTHR, 0);
    if (per_cu > 1) per_cu = 1;
    grid_blocks = cus * per_cu;
  }
  int ph0 = 0, ph1 = NPHASE, which = 3;
  void* args[] = {&p, &ph0, &ph1, &which};
  hipError_t e = hipLaunchCooperativeKernel((void*)k_mega, dim3(grid_blocks), dim3(NTHR), args, 0, stream);
  if (e != hipSuccess) fprintf(stderr, "cooperative launch failed: %s (grid %d)\n", hipGetErrorString(e), grid_blocks);
#else
  const int G = 256;
#ifndef REPWH
#define REPWH 0
#endif
#ifndef HOSTREP
#define HOSTREP 0
#endif
#define LAUNCH_PH(ph, wh) { k_mega<<<G, NTHR, 0, stream>>>(p, ph, (ph) + 1, wh); \
    if ((HOSTREP >> ((((ph) - 1) % 5) + 5 * ((((ph) - 1) / 5) & 1))) & 1) { hipMemsetAsync(p.ctr, 0, 512, stream); k_mega<<<G, NTHR, 0, stream>>>(p, ph, (ph) + 1, REPWH ? REPWH : (wh)); } }
  k_mega<<<G, NTHR, 0, stream>>>(p, 0, 1, 3);
  for (int layer = 0; layer < 4; ++layer) {
    const int j = layer >> 1; const int pb = 1 + layer * 5;
    if ((layer & 1) == 0) {
      if (FASTMASK & 1) LAUNCH_PH(pb, 3) else nv_gemm<0><<<(unsigned)(((size_t)NB * NR * 4096 + 255) / 256), 256, 0, stream>>>(p, j);
      const int which = ((FASTMASK & 2) ? 1 : 0) | ((FASTMASK & 4) ? 2 : 0);
      if (which) LAUNCH_PH(pb + 2, which)
      if (!(FASTMASK & 2)) nv_attn<0><<<NB * NR * 4 / 2, 128, 0, stream>>>(p, j);
      if (!(FASTMASK & 4)) nv_attn<1><<<NB * NR * 8 / 2, 128, 0, stream>>>(p, j);
      if (FASTMASK & 8) { k_mega<<<G, NTHR, 0, stream>>>(p, pb + 3, pb + 4, 3); k_mega<<<G, NTHR, 0, stream>>>(p, pb + 4, pb + 5, 3); }
      else nv_out_ln<<<NB * NR, 256, 0, stream>>>(p, layer, p.R0, p.W_evout + (size_t)j * 1024 * 1024);
    } else {
      if (FASTMASK & 16) LAUNCH_PH(pb, 3) else nv_gemm<1><<<(unsigned)(((size_t)NB * NR * 1856 + 255) / 256), 256, 0, stream>>>(p, j);
      if (FASTMASK & 32) LAUNCH_PH(pb + 1, 3)
      else { nv_gemm<2><<<(unsigned)(((size_t)NB * NR * 1536 + 255) / 256), 256, 0, stream>>>(p, j); nv_gemm<3><<<(unsigned)(((size_t)NB * NR * 2048 + 255) / 256), 256, 0, stream>>>(p, j); }
      if (FASTMASK & 64) LAUNCH_PH(pb + 2, 3) else nv_attn<2><<<NB * NR * 8 / 2, 128, 0, stream>>>(p, j);
      if (FASTMASK & 8) { k_mega<<<G, NTHR, 0, stream>>>(p, pb + 3, pb + 4, 3); k_mega<<<G, NTHR, 0, stream>>>(p, pb + 4, pb + 5, 3); }
      else nv_out_ln<<<NB * NR, 256, 0, stream>>>(p, layer, p.R3, p.W_odout + (size_t)j * 1024 * 1024);
    }
  }
#endif
}
```

```cpp
#include <hip/hip_runtime.h>
#include <hip/hip_cooperative_groups.h>
#include <stdint.h>
#include <stdio.h>
namespace cg = cooperative_groups;

typedef unsigned short bf16_t;
#define DI __device__ __forceinline__

constexpr int NB = 4, SEQ = 4096, DM = 1024, LP = 4352, MP = NB * LP, OFF = 240;
constexpr float LOG2E = 1.4426950408889634f;
constexpr float ALPHA = 1.681792830507429f;
constexpr float QS64 = 0.125f * LOG2E;
constexpr float QS192 = 0.07216878364870323f * LOG2E;

DI float bf2f(bf16_t v) { return __uint_as_float(((unsigned)v) << 16); }
DI bf16_t f2bf(float f) { unsigned u = __float_as_uint(f); u += 0x7fffu + ((u >> 16) & 1u); return (bf16_t)(u >> 16); }
DI float lo16(unsigned v) { return __uint_as_float(v << 16); }
DI float hi16(unsigned v) { return __uint_as_float(v & 0xffff0000u); }
DI int opaque_tid() { int t = threadIdx.x; asm volatile("" : "+v"(t)); return t; }

struct Params {
  const float *x, *meta, *ln_g, *ln_b, *ev_w_in, *ev_w_out, *lq1, *lk1, *lq2, *lk2, *subln, *od_w_in, *od_qn, *od_w_uq, *od_kvn, *od_w_ukv, *od_w_out;
  float* out;
  bf16_t *W_evin, *W_evout, *W_odin, *W_oduq, *W_odukv, *W_odout;
  bf16_t *R0, *R1, *R2, *R3;
  float *hmeta, *rope, *lam, *rowss, *rsarr;
  unsigned* ctr;
  unsigned* bar;
  unsigned* pcnt;
  float* xch;
};

DI float* hrow(const Params& p, int b, int pp) {
  return pp >= 256 ? p.out + ((size_t)(b * SEQ + pp - 256)) * DM : p.hmeta + ((size_t)(b * 64 + pp - 192)) * DM;
}

DI int wmap(int mode, int n) {
  if (mode == 1) {
    if (n < 1024) return n;
    if (n < 1536) return n + 512;
    if (n < 2048) return n + 512;
    if (n < 2560) return n + 512;
    if (n < 3072) return n + 1024;
    if (n < 3584) return n - 2048;
    return n - 512;
  }
  if (mode == 2) {
    if (n < 768) return n;
    if (n < 1792) return n + 64;
    if (n < 1856) return n - 1024;
    return -1;
  }
  if (mode == 4) {
    if (n < 1024) return 256 * (n >> 7) + (n & 127);
    const int m = n - 1024; return 256 * (m >> 7) + 128 + (m & 127);
  }
  return n;
}
DI float wcolscale(int mode, int n) {
  if (mode == 1) return (n < 512 || (n >= 1536 && n < 2048)) ? QS64 : 1.0f;
  if (mode == 3) return QS192;
  return 1.0f;
}
constexpr int CT_EVIN = 1024, CT_EVOUT = 256, CT_ODIN = 512, CT_ODUQ = 192, CT_ODUKV = 128, CT_ODOUT = 256;
constexpr int CT_PER_LAYER = CT_EVIN + CT_EVOUT + CT_ODIN + CT_ODUQ + CT_ODUKV + CT_ODOUT;
constexpr int CT_TOTAL = 2 * CT_PER_LAYER;
struct ConvDesc { const float* W; bf16_t* Wt; const float* kscale; int K, Nsrc, mode, kt, nt; };
DI ConvDesc conv_desc(const Params& p, int t) {
  ConvDesc d; const int j = t / CT_PER_LAYER; int u = t % CT_PER_LAYER; d.kscale = nullptr;
  if (u < CT_EVIN) { d.W = p.ev_w_in + (size_t)j * 1024 * 4096; d.Wt = p.W_evin + (size_t)j * 4096 * 1024; d.K = 1024; d.Nsrc = 4096; d.mode = 1; d.kt = u & 15; d.nt = u >> 4; return d; }
  u -= CT_EVIN;
  if (u < CT_EVOUT) { d.W = p.ev_w_out + (size_t)j * 1024 * 1024; d.Wt = p.W_evout + (size_t)j * 1024 * 1024; d.K = 1024; d.Nsrc = 1024; d.mode = 0; d.kt = u & 15; d.nt = u >> 4; return d; }
  u -= CT_EVOUT;
  if (u < CT_ODIN) { d.W = p.od_w_in + (size_t)j * 1024 * 1856; d.Wt = p.W_odin + (size_t)j * 2048 * 1024; d.K = 1024; d.Nsrc = 1856; d.mode = 2; d.kt = u & 15; d.nt = u >> 4; return d; }
  u -= CT_ODIN;
  if (u < CT_ODUQ) { d.W = p.od_w_uq + (size_t)j * 512 * 1536; d.Wt = p.W_oduq + (size_t)j * 1536 * 512; d.K = 512; d.Nsrc = 1536; d.mode = 3; d.kscale = p.od_qn + j * 512; d.kt = u & 7; d.nt = u >> 3; return d; }
  u -= CT_ODUQ;
  if (u < CT_ODUKV) { d.W = p.od_w_ukv + (size_t)j * 256 * 2048; d.Wt = p.W_odukv + (size_t)j * 2048 * 256; d.K = 256; d.Nsrc = 2048; d.mode = 4; d.kscale = p.od_kvn + j * 256; d.kt = u & 3; d.nt = u >> 2; return d; }
  u -= CT_ODUKV;
  d.W = p.od_w_out + (size_t)j * 1024 * 1024; d.Wt = p.W_odout + (size_t)j * 1024 * 1024; d.K = 1024; d.Nsrc = 1024; d.mode = 0; d.kt = u & 15; d.nt = u >> 4; return d;
}
DI void conv_load(const ConvDesc& d, int tid, float4& v0, float4& v1) {
  const int src0 = wmap(d.mode, d.nt * 64); const int kk = tid >> 4, n4 = (tid & 15) * 4;
  v0 = make_float4(0.f, 0.f, 0.f, 0.f); v1 = v0;
  if (src0 >= 0) { typedef float f4_t __attribute__((ext_vector_type(4))); const float* s = d.W + (size_t)(d.kt * 64 + kk) * d.Nsrc + src0 + n4;
    const f4_t a = __builtin_nontemporal_load((const f4_t*)s), b = __builtin_nontemporal_load((const f4_t*)(s + (size_t)32 * d.Nsrc));
    v0 = make_float4(a[0], a[1], a[2], a[3]); v1 = make_float4(b[0], b[1], b[2], b[3]); }
}
DI void conv_all(const Params& p, float* lds, int tid) {
  int t = blockIdx.x; if (t >= CT_TOTAL) return;
  ConvDesc d = conv_desc(p, t); float4 v0, v1; conv_load(d, tid, v0, v1);
  for (;;) {
    { const int kk = tid >> 4, n4 = (tid & 15) * 4; float* a = lds + kk * 65 + n4; a[0] = v0.x; a[1] = v0.y; a[2] = v0.z; a[3] = v0.w; float* c = a + 32 * 65; c[0] = v1.x; c[1] = v1.y; c[2] = v1.z; c[3] = v1.w; }
    __syncthreads();
    const ConvDesc cur = d; const int tn = t + gridDim.x; const bool more = tn < CT_TOTAL;
    if (more) { d = conv_desc(p, tn); conv_load(d, tid, v0, v1); }
    { const float cs = wcolscale(cur.mode, cur.nt * 64); const int nn = tid >> 3, k8 = (tid & 7) * 8; const int k = cur.kt * 64 + k8;
      float v[8];
#pragma unroll
      for (int jj = 0; jj < 8; ++jj) { v[jj] = lds[(k8 + jj) * 65 + nn] * cs; if (cur.kscale) v[jj] *= cur.kscale[k + jj]; }
      uint4 o; o.x = (unsigned)f2bf(v[0]) | ((unsigned)f2bf(v[1]) << 16); o.y = (unsigned)f2bf(v[2]) | ((unsigned)f2bf(v[3]) << 16);
      o.z = (unsigned)f2bf(v[4]) | ((unsigned)f2bf(v[5]) << 16); o.w = (unsigned)f2bf(v[6]) | ((unsigned)f2bf(v[7]) << 16);
      *(uint4*)(cur.Wt + (size_t)(cur.nt * 64 + nn) * cur.K + k) = o; }
    __syncthreads();
    if (!more) break;
    t = tn;
  }
}
DI void prep_elem(const Params& p, size_t gtid, size_t gsize) {
  for (size_t i = gtid; i < (size_t)MP * 128; i += gsize) {
    const int m = (int)(i >> 7), c8 = (int)(i & 127) * 8; const int b = m / LP, pp = m % LP;
    float4 v0 = make_float4(0.f, 0.f, 0.f, 0.f), v1 = v0;
    if (pp >= 256) { const float* sp = p.x + ((size_t)(b * SEQ + pp - 256)) * DM + c8; v0 = *(const float4*)sp; v1 = *(const float4*)(sp + 4); }
    else if (pp >= OFF) { const float* sp = p.meta + (size_t)(pp - OFF) * DM + c8; v0 = *(const float4*)sp; v1 = *(const float4*)(sp + 4); }
    if (pp >= 192 && pp < 256) { float* hp = hrow(p, b, pp) + c8; *(float4*)hp = v0; *(float4*)(hp + 4) = v1; }
    uint4 w; w.x = (unsigned)f2bf(v0.x) | ((unsigned)f2bf(v0.y) << 16); w.y = (unsigned)f2bf(v0.z) | ((unsigned)f2bf(v0.w) << 16);
    w.z = (unsigned)f2bf(v1.x) | ((unsigned)f2bf(v1.y) << 16); w.w = (unsigned)f2bf(v1.z) | ((unsigned)f2bf(v1.w) << 16);
    *(uint4*)(p.R0 + (size_t)m * DM + c8) = w;
  }
  for (size_t i = gtid; i < (size_t)LP * 32; i += gsize) {
    const int pp = (int)(i >> 5), f = (int)(i & 31); const int pos = pp >= OFF ? pp - OFF : 0;
    const float inv = powf(10000.0f, -(float)f / 32.0f);
    const float ang = (float)pos * inv;
    const double x = (double)ang; const double n = rint(x * 0.15915494309189535); const double r = x - n * 6.283185307179586;
    const float rf = (float)r;
    p.rope[(size_t)pp * 64 + f] = cosf(rf); p.rope[(size_t)pp * 64 + 32 + f] = sinf(rf);
  }
  if (gtid < 2) {
    const int j = (int)gtid; float d1 = 0.f, d2 = 0.f;
    for (int i = 0; i < 64; ++i) { d1 += p.lq1[j * 64 + i] * p.lk1[j * 64 + i]; d2 += p.lq2[j * 64 + i] * p.lk2[j * 64 + i]; }
    const float lam_init = 0.8f - 0.6f * expf(-0.3f * (float)(2 * j));
    p.lam[j * 2] = expf(d1) - expf(d2) + lam_init; p.lam[j * 2 + 1] = lam_init;
  }
  if (gtid < 128) p.ctr[gtid] = 0u;
}

__global__ void __launch_bounds__(256) k_prep(Params p) {
  __shared__ float lds[64 * 65];
  prep_elem(p, (size_t)blockIdx.x * 256 + threadIdx.x, (size_t)gridDim.x * 256);
}

DI float dotbf(const bf16_t* a, const bf16_t* w, int K) {
  float s = 0.f;
  for (int k = 0; k < K; k += 8) {
    const uint4 av = *(const uint4*)(a + k), wv = *(const uint4*)(w + k);
    s += lo16(av.x) * lo16(wv.x) + hi16(av.x) * hi16(wv.x) + lo16(av.y) * lo16(wv.y) + hi16(av.y) * hi16(wv.y)
       + lo16(av.z) * lo16(wv.z) + hi16(av.z) * hi16(wv.z) + lo16(av.w) * lo16(wv.w) + hi16(av.w) * hi16(wv.w);
  }
  return s;
}
DI float sumsq(const bf16_t* a, int K) { float s = 0.f; for (int k = 0; k < K; ++k) { const float v = bf2f(a[k]); s += v * v; } return s; }
DI float rope_apply(const float* rope, int pp, int d, float v, float v2) {
  const float c = rope[(size_t)pp * 64 + (d & 31)], s = rope[(size_t)pp * 64 + 32 + (d & 31)];
  return d < 32 ? v * c - v2 * s : v * c + v2 * s;
}
constexpr int NR = 4160;
template <int MODE> __global__ void __launch_bounds__(256) nv_gemm(Params p, int j) {
  constexpr int N = MODE == 0 ? 4096 : MODE == 1 ? 1856 : MODE == 2 ? 1536 : 2048;
  const size_t idx = (size_t)blockIdx.x * 256 + threadIdx.x;
  if (idx >= (size_t)NB * NR * N) return;
  const int n = (int)(idx % N); const int mi = (int)(idx / N); const int b = mi / NR, pp = 192 + mi % NR; const size_t m = (size_t)b * LP + pp;
  if (MODE == 0) {
    const float acc = dotbf(p.R0 + m * DM, p.W_evin + (size_t)j * 4096 * 1024 + (size_t)n * 1024, 1024);
    if (n < 3072) p.R2[m * 3072 + n] = f2bf(acc); else p.R1[((size_t)b * 1024 + n - 3072) * LP + pp] = f2bf(acc);
  } else if (MODE == 1) {
    const bf16_t* W = p.W_odin + (size_t)j * 2048 * 1024; const bf16_t* a = p.R0 + m * DM;
    const float acc = dotbf(a, W + (size_t)n * 1024, 1024);
    if (n < 768) p.R3[m * 768 + n] = f2bf(acc);
    else if (n < 1792) p.R2[m * 1024 + n - 768] = f2bf(acc);
    else { const int d = n - 1792; const float v2 = dotbf(a, W + (size_t)(1792 + (d ^ 32)) * 1024, 1024);
           p.R2[(size_t)MP * 2560 + m * 64 + d] = f2bf(rope_apply(p.rope, pp, d, acc, v2)); }
  } else if (MODE == 2) {
    const bf16_t* W = p.W_oduq + (size_t)j * 1536 * 512; const bf16_t* a = p.R3 + m * 768;
    const float rs = rsqrtf(sumsq(a, 512) * (1.0f / 512.0f) + 1e-6f);
    float v = dotbf(a, W + (size_t)n * 512, 512) * rs;
    const int dd = n % 192;
    if (dd >= 128) { const int d = dd - 128; const float v2 = dotbf(a, W + (size_t)(n - d + (d ^ 32)) * 512, 512) * rs; v = rope_apply(p.rope, pp, d, v, v2); }
    p.R2[(size_t)MP * 1024 + m * 1536 + n] = f2bf(v);
  } else {
    const bf16_t* W = p.W_odukv + (size_t)j * 2048 * 256; const bf16_t* a = p.R3 + m * 768 + 512;
    const float rs = rsqrtf(sumsq(a, 256) * (1.0f / 256.0f) + 1e-6f);
    const float v = dotbf(a, W + (size_t)n * 256, 256) * rs;
    if (n < 1024) p.R0[m * 1024 + n] = f2bf(v); else p.R1[((size_t)b * 1024 + n - 1024) * LP + pp] = f2bf(v);
  }
}
DI float wave_sum(float v) { for (int o = 32; o; o >>= 1) v += __shfl_xor(v, o); return v; }
DI float wave_max(float v) { for (int o = 32; o; o >>= 1) v = fmaxf(v, __shfl_xor(v, o)); return v; }
DI float silu(float g) { return g / (1.0f + __expf(-g)); }
template <int MODE> __global__ void __launch_bounds__(128) nv_attn(Params p, int j) {
  __shared__ float sc[2][2][LP];
  __shared__ float qs[2][192];
  constexpr int NH = MODE == 0 ? 4 : 8;
  const int wave = threadIdx.x >> 6, lane = threadIdx.x & 63;
  const int gq = blockIdx.x * 2 + wave; const int qi = gq % NR, bh = gq / NR; const int b = bh / NH, h = bh % NH; const int pp = 192 + qi;
  const size_t m = (size_t)b * LP + pp;
  const int kbeg = OFF; const int kend = MODE == 1 ? pp : (pp / 64 + 1) * 64;
  float* s0 = sc[wave][0]; float* s1 = sc[wave][1];
  if (MODE == 0) { for (int d = lane; d < 128; d += 64) qs[wave][d] = bf2f(p.R2[m * 3072 + 128 * h + d]); }
  if (MODE == 1) { qs[wave][lane] = bf2f(p.R2[m * 3072 + 1536 + 64 * h + lane]); }
  if (MODE == 2) { for (int d = lane; d < 192; d += 64) qs[wave][d] = bf2f(p.R2[(size_t)MP * 1024 + m * 1536 + 192 * h + d]); }
  __syncthreads();
  const float* q = qs[wave];
  for (int k = kbeg + lane; k < kend; k += 64) {
    const size_t mk = (size_t)b * LP + k;
    if (MODE == 0) {
      const bf16_t* kr = p.R2 + mk * 3072 + 512 + 128 * h; float a0 = 0.f, a1 = 0.f;
      for (int d = 0; d < 64; ++d) { a0 += q[d] * bf2f(kr[d]); a1 += q[64 + d] * bf2f(kr[64 + d]); }
      const float sl = exp2f(-2.0f * (float)(h + 1)) * LOG2E * fabsf((float)(pp - k));
      s0[k] = a0 - sl; s1[k] = a1 - sl;
    } else if (MODE == 1) {
      const bf16_t* kr = p.R2 + mk * 3072 + 2048 + 64 * h; float a0 = 0.f;
      for (int d = 0; d < 64; ++d) a0 += q[d] * bf2f(kr[d]);
      s0[k] = a0;
    } else {
      const bf16_t* kr = p.R0 + mk * 1024 + 128 * h; const bf16_t* kp = p.R2 + (size_t)MP * 2560 + mk * 64; float a0 = 0.f;
      for (int d = 0; d < 128; ++d) a0 += q[d] * bf2f(kr[d]);
      for (int d = 0; d < 64; ++d) a0 += q[128 + d] * bf2f(kp[d]);
      s0[k] = a0;
    }
  }
  __syncthreads();
  if (MODE == 1) {
    if (lane == 0) { float S = 0.f; for (int k = pp - 1; k >= kbeg; --k) { const float z = s0[k]; const float ls = -(fmaxf(z, 0.f) + log2f(1.0f + exp2f(-fabsf(z)))); S += ls; s0[k] = exp2f(z + S); } }
  } else {
    float m0 = -INFINITY, m1 = -INFINITY;
    for (int k = kbeg + lane; k < kend; k += 64) { m0 = fmaxf(m0, s0[k]); if (MODE == 0) m1 = fmaxf(m1, s1[k]); }
    m0 = wave_max(m0); if (MODE == 0) m1 = wave_max(m1);
    float l0 = 0.f, l1 = 0.f;
    for (int k = kbeg + lane; k < kend; k += 64) { l0 += exp2f(s0[k] - m0); if (MODE == 0) l1 += exp2f(s1[k] - m1); }
    l0 = wave_sum(l0); if (MODE == 0) l1 = wave_sum(l1);
    const float lam = MODE == 0 ? p.lam[2 * j] : 0.f;
    for (int k = kbeg + lane; k < kend; k += 64) {
      float w = exp2f(s0[k] - m0) / l0; if (MODE == 0) w -= lam * exp2f(s1[k] - m1) / l1;
      s0[k] = w;
    }
  }
  __syncthreads();
  if (MODE == 0) {
    float o[2];
    for (int t = 0; t < 2; ++t) { const int d = lane + 64 * t; const bf16_t* vr = p.R1 + ((size_t)b * 1024 + 128 * h + d) * LP; float a = 0.f; for (int k = kbeg; k < kend; ++k) a += s0[k] * bf2f(vr[k]); o[t] = a; }
    const float ss = wave_sum(o[0] * o[0] + o[1] * o[1]);
    const float r = rsqrtf(ss * (1.0f / 128.0f) + 1e-6f) * (1.0f - p.lam[2 * j + 1]);
    for (int t = 0; t < 2; ++t) { const int d = lane + 64 * t; const float g = bf2f(p.R2[m * 3072 + 1024 + 128 * h + d]);
      p.R0[m * 1024 + 128 * h + d] = f2bf(o[t] * r * p.subln[j * 128 + d] * silu(g)); }
  } else if (MODE == 1) {
    const int d = lane; const bf16_t* vr = p.R1 + ((size_t)b * 1024 + 512 + 64 * h + d) * LP; float a = 0.f;
    for (int k = kbeg; k < kend; ++k) a += s0[k] * bf2f(vr[k]);
    const float g = bf2f(p.R2[m * 3072 + 2560 + 64 * h + d]);
    p.R0[m * 1024 + 512 + 64 * h + d] = f2bf(a * silu(g));
  } else {
    for (int t = 0; t < 2; ++t) { const int d = lane + 64 * t; const bf16_t* vr = p.R1 + ((size_t)b * 1024 + 128 * h + d) * LP; float a = 0.f; for (int k = kbeg; k < kend; ++k) a += s0[k] * bf2f(vr[k]);
      const float g = bf2f(p.R2[m * 1024 + 128 * h + d]);
      p.R3[m * 1024 + 128 * h + d] = f2bf(a * silu(g)); }
  }
}
__global__ void __launch_bounds__(256) nv_out_ln(Params p, int layer, const bf16_t* Y, const bf16_t* Wt) {
  __shared__ float red[8];
  const int mi = blockIdx.x; const int b = mi / NR, pp = 192 + mi % NR; const size_t m = (size_t)b * LP + pp;
  const int tid = threadIdx.x, lane = tid & 63, wave = tid >> 6;
  float* hr = hrow(p, b, pp);
  float z[4]; float s = 0.f;
  for (int i = 0; i < 4; ++i) { const int n = tid + 256 * i; z[i] = ALPHA * hr[n] + dotbf(Y + m * 1024, Wt + (size_t)n * 1024, 1024); s += z[i]; }
  s = wave_sum(s); if (lane == 0) red[wave] = s; __syncthreads();
  const float mean = (red[0] + red[1] + red[2] + red[3]) * (1.0f / 1024.0f);
  float v = 0.f; for (int i = 0; i < 4; ++i) { const float d = z[i] - mean; v += d * d; }
  v = wave_sum(v); if (lane == 0) red[4 + wave] = v; __syncthreads();
  const float rstd = rsqrtf((red[4] + red[5] + red[6] + red[7]) * (1.0f / 1024.0f) + 1e-5f);
  for (int i = 0; i < 4; ++i) { const int n = tid + 256 * i; const float o = (z[i] - mean) * rstd * p.ln_g[layer * 1024 + n] + p.ln_b[layer * 1024 + n]; hr[n] = o; p.R0[m * 1024 + n] = f2bf(o); }
}


typedef short bf16x8 __attribute__((ext_vector_type(8)));
typedef short s16x4 __attribute__((ext_vector_type(4)));
typedef float f32x16 __attribute__((ext_vector_type(16)));
typedef __bf16 bf2_t __attribute__((ext_vector_type(2)));
typedef float f2_t __attribute__((ext_vector_type(2)));
#define MFMA32(a, b, c) __builtin_amdgcn_mfma_f32_32x32x16_bf16((a), (b), (c), 0, 0, 0)
DI unsigned pk2(float a, float b) { f2_t v = {a, b}; bf2_t r = __builtin_convertvector(v, bf2_t); return __builtin_bit_cast(unsigned, r); }
DI uint2 pk4(float a, float b, float c, float d) { uint2 r; r.x = pk2(a, b); r.y = pk2(c, d); return r; }
DI float ex2(float x) { return __builtin_amdgcn_exp2f(x); }
DI float lg2(float x) { return __builtin_amdgcn_logf(x); }
DI float silu_f(float g) { return g * __builtin_amdgcn_rcpf(1.0f + ex2(-g * LOG2E)); }
DI bf16x8 pack_step(const f32x16& x, int s) {
  uint4 u; u.x = pk2(x[8 * s], x[8 * s + 1]); u.y = pk2(x[8 * s + 2], x[8 * s + 3]); u.z = pk2(x[8 * s + 4], x[8 * s + 5]); u.w = pk2(x[8 * s + 6], x[8 * s + 7]);
  return __builtin_bit_cast(bf16x8, u);
}
DI bf16x8 ld_frag(const char* a) { return *(const bf16x8*)a; }
DI void store_pair16(bf16_t* rowp, int colbase, int hh, uint2 a, uint2 b) {
  const auto r0 = __builtin_amdgcn_permlane32_swap(a.x, b.x, false, false), r1 = __builtin_amdgcn_permlane32_swap(a.y, b.y, false, false);
  uint4 o; o.x = r0[0]; o.y = r1[0]; o.z = r0[1]; o.w = r1[1];
  *(uint4*)(rowp + colbase + 8 * hh) = o;
}
DI float x32_max(float x) { auto rr = __builtin_amdgcn_permlane32_swap(__float_as_uint(x), __float_as_uint(x), false, false); return fmaxf(__uint_as_float(rr[0]), __uint_as_float(rr[1])); }
DI float x32_sum(float x) { auto rr = __builtin_amdgcn_permlane32_swap(__float_as_uint(x), __float_as_uint(x), false, false); return __uint_as_float(rr[0]) + __uint_as_float(rr[1]); }
DI bf16x8 ld_vfrag(const char* a) {
  const uint2 lo = *(const uint2*)a, hi = *(const uint2*)(a + 16); uint4 u; u.x = lo.x; u.y = lo.y; u.z = hi.x; u.w = hi.y; return __builtin_bit_cast(bf16x8, u);
}
constexpr int SMEM_BYTES = 133120, SM_SLOT = 132608;
constexpr int NTHR = 512;

namespace pg8 {
#define PG8_LAS __attribute__((address_space(3)))
typedef unsigned short bf16_t;
typedef short bf16x8 __attribute__((ext_vector_type(8)));
typedef float f32x4 __attribute__((ext_vector_type(4)));
typedef unsigned u32x4 __attribute__((ext_vector_type(4)));
constexpr int BM = 256, BK = 64, HALF = 128, HTB = HALF * BK * 2  , STAGE_BYTES = 8 * HTB, NXCD = 8, WGM = 8;

__host__ __device__ __forceinline__ int lds_byte(int r, int c) { const int st = (r >> 4) * 2 + (c >> 5), rr = r & 15, cc = c & 31, ob = rr * 64 + cc * 2; return st * 1024 + (ob ^ (((ob >> 9) & 1) << 5)); }
__host__ __device__ __forceinline__ void stage_rc(int b, int& R, int& C) { const int st = b / 1024, sb = b % 1024, swz = sb ^ (((sb >> 9) & 1) << 5); R = (st >> 1) * 16 + swz / 64; C = (st & 1) * 32 + (swz % 64) / 2; }
__host__ __device__ __forceinline__ int perm32(int rho) { const int n = rho >> 4, i = rho & 15; return 8 * (i >> 2) + 4 * n + (i & 3); }

struct Unit { int pm, pn; };
struct Gemm { const bf16_t* A; const bf16_t* Bt; int M, N, K; };

struct StaticOrder {
    int nM, nN, nwg, G, c;
    __host__ __device__ void init(int M, int N, int G_, int c_) { nM = M / BM; nN = N / BM; nwg = nM * nN; G = G_; c = c_; }
    __host__ __device__ bool next(int i, Unit& u) const {
        const long L = (long)i * G + c; if (L >= nwg) return false;
        int wgid = (int)L; { const int q = nwg / NXCD, r = nwg % NXCD, xcd = wgid % NXCD, off = wgid / NXCD; wgid = (xcd < r ? xcd * (q + 1) : r * (q + 1) + (xcd - r) * q) + off; }
        const int nig = WGM * nN, gid = wgid / nig, fm = gid * WGM, gsz = (nM - fm) < WGM ? (nM - fm) : WGM;
        u.pm = fm + ((wgid % nig) % gsz); u.pn = (wgid % nig) / gsz; return true;
    }
    __device__ __forceinline__ void a_ready(const Unit&) const {}
    __device__ __forceinline__ void done(const Unit&) const {}
};


struct FrameOrder {
    StaticOrder S;
    __device__ __forceinline__ void init(int nN, int G, int c) { S.nM = 64; S.nN = nN; S.nwg = 64 * nN; S.G = G; S.c = c; }
    __device__ __forceinline__ bool next(int i, Unit& u) const { if (!S.next(i, u)) return false; u.pm = (u.pm >> 4) * 17 + 1 + (u.pm & 15); return true; }
    __device__ __forceinline__ void a_ready(const Unit&) const {}
    __device__ __forceinline__ void done(const Unit&) const {}
};
struct ListOrder {
    int cnt, base, stride, nN;
    __device__ __forceinline__ bool next(int i, Unit& u) const { if (i >= cnt) return false; const int L = base + i * stride; const int pmf = L / nN; u.pn = L % nN; u.pm = (pmf >> 4) * 17 + 1 + (pmf & 15); return true; }
    __device__ __forceinline__ void a_ready(const Unit&) const {}
    __device__ __forceinline__ void done(const Unit&) const {}
};
template <int SUB> struct EpiMix {
    static constexpr bool PERM = true, AFTER_DRAIN = false;
    const Params* pp_; int first;
    __device__ __forceinline__ void vt_store(bf16_t* vt, const u32x4 w) const {
        vt[0] = (bf16_t)w.x; vt[LP] = (bf16_t)(w.x >> 16); vt[2 * LP] = (bf16_t)w.y; vt[3 * LP] = (bf16_t)(w.y >> 16);
        vt[4 * LP] = (bf16_t)w.z; vt[5 * LP] = (bf16_t)(w.z >> 16); vt[6 * LP] = (bf16_t)w.w; vt[7 * LP] = (bf16_t)(w.w >> 16); }
    __device__ __forceinline__ void operator()(const f32x4 (&acc)[2][2][4][2], const Unit& u, int wr, int wc, int fr_, int fq_) const {
        const Params& p = *pp_;
        const int t_ = opaque_tid(), fr = t_ & 15, fq = (t_ >> 4) & 3;
        const int b = u.pm / 17, ppb = (u.pm % 17) * 256 + wr * 64 + fr, c8 = 8 * fq;
#pragma unroll
        for (int ai = 0; ai < 2; ++ai)
#pragma unroll
            for (int m = 0; m < 4; ++m) {
                const int pp = ppb + ai * 128 + m * 16; const size_t mrow = (size_t)b * LP + pp;
                float rs = 1.0f;
                if (SUB == 2) rs = p.rsarr[mrow * 2];
                if (SUB == 3) rs = p.rsarr[mrow * 2 + 1];
#pragma unroll
                for (int bj = 0; bj < 2; ++bj) {
                    const int cg = u.pn * 256 + bj * 128 + wc * 32;
                    const f32x4 v0 = acc[ai][bj][m][0] * rs, v1 = acc[ai][bj][m][1] * rs;
                    if (SUB == 4) {
                        const size_t ho = ((size_t)(b * SEQ + pp - 256)) * DM + cg + c8; float* hr = p.out + ho; const float* hs = (first ? p.x : p.out) + ho;
                        const f32x4 h0 = *(const f32x4*)hs, h1 = *(const f32x4*)(hs + 4);
                        *(f32x4*)hr = h0 * ALPHA + v0; *(f32x4*)(hr + 4) = h1 * ALPHA + v1;
                    } else {
                        u32x4 w; w.x = pk2(v0[0], v0[1]); w.y = pk2(v0[2], v0[3]); w.z = pk2(v1[0], v1[1]); w.w = pk2(v1[2], v1[3]);
                        if (SUB == 0) {
                            if (cg < 3072) { *(u32x4*)(p.R2 + mrow * 3072 + cg + c8) = w;
                                if (cg >= 512 && cg < 1024) {
                                    float ss = (v0[0] * v0[0] + v0[1] * v0[1]) + (v0[2] * v0[2] + v0[3] * v0[3]) + (v1[0] * v1[0] + v1[1] * v1[1]) + (v1[2] * v1[2] + v1[3] * v1[3]);
                                    ss += __shfl_xor(ss, 16); ss += __shfl_xor(ss, 32);
                                    if (fq == 0) p.rowss[mrow * 24 + ((cg - 512) >> 5)] = ss; } }
                            else vt_store(p.R1 + ((size_t)b * 1024 + (cg - 3072 + c8)) * LP + pp, w);
                        } else if (SUB == 1) {
                            if (cg < 768) {
                                if (cg < 512) *(u32x4*)(p.R3 + mrow * 512 + cg + c8) = w; else *(u32x4*)(p.R3 + (size_t)MP * 512 + mrow * 256 + (cg - 512) + c8) = w;
                                float ss = (v0[0] * v0[0] + v0[1] * v0[1]) + (v0[2] * v0[2] + v0[3] * v0[3]) + (v1[0] * v1[0] + v1[1] * v1[1]) + (v1[2] * v1[2] + v1[3] * v1[3]);
                                ss += __shfl_xor(ss, 16); ss += __shfl_xor(ss, 32);
                                if (fq == 0) p.rowss[mrow * 24 + (cg >> 5)] = ss;
                            } else if (cg < 1792) *(u32x4*)(p.R2 + mrow * 1024 + (cg - 768) + c8) = w;
                            else if (cg < 1856) *(u32x4*)(p.R2 + (size_t)MP * 2624 + mrow * 64 + (cg - 1792) + c8) = w;
                        } else if (SUB == 2) {
                            *(u32x4*)(p.R2 + (size_t)MP * 1024 + mrow * 1536 + cg + c8) = w;
                        } else {
                            if (cg < 1024) *(u32x4*)(p.R0 + mrow * 1024 + cg + c8) = w;
                            else vt_store(p.R1 + ((size_t)b * 1024 + (cg - 1024 + c8)) * LP + pp, w);
                        }
                    }
                }
            }
    }
};
struct EpiOutLn {
    static constexpr bool PERM = true, AFTER_DRAIN = true;
    const Params* pp_; int first, layer;
    __device__ __forceinline__ void fused(f32x4 (&acc)[2][2][4][2], const Unit& u, int wr, int wc, int fr_, int fq_, PG8_LAS unsigned char* ldsp, int wid, int lane_) const {
        const Params& p = *pp_;
        char* sm = (char*)ldsp;
        float2* part = (float2*)sm;
        float2* tab = (float2*)(sm + 8192);
        const int t_ = opaque_tid(), fr = t_ & 15, fq = (t_ >> 4) & 3, c8 = 8 * fq;
        const int b = u.pm / 17, pp0 = (u.pm % 17) * 256;
        const float* hsrc = first ? p.x : p.out;
#pragma unroll
        for (int ai = 0; ai < 2; ++ai)
#pragma unroll
            for (int m = 0; m < 4; ++m) {
                const int rowl = ai * 128 + wr * 64 + m * 16 + fr; const size_t ho = ((size_t)(b * SEQ + pp0 + rowl - 256)) * DM + u.pn * 256 + wc * 32 + c8;
                float s1 = 0.f, s2 = 0.f;
#pragma unroll
                for (int bj = 0; bj < 2; ++bj) {
                    const f32x4 h0 = *(const f32x4*)(hsrc + ho + bj * 128), h1 = *(const f32x4*)(hsrc + ho + bj * 128 + 4);
                    const f32x4 z0 = h0 * ALPHA + acc[ai][bj][m][0], z1 = h1 * ALPHA + acc[ai][bj][m][1];
                    acc[ai][bj][m][0] = z0; acc[ai][bj][m][1] = z1;
                    s1 += ((z0[0] + z0[1]) + (z0[2] + z0[3])) + ((z1[0] + z1[1]) + (z1[2] + z1[3]));
                    s2 += ((z0[0] * z0[0] + z0[1] * z0[1]) + (z0[2] * z0[2] + z0[3] * z0[3])) + ((z1[0] * z1[0] + z1[1] * z1[1]) + (z1[2] * z1[2] + z1[3] * z1[3]));
                }
                s1 += __shfl_xor(s1, 16); s1 += __shfl_xor(s1, 32); s2 += __shfl_xor(s2, 16); s2 += __shfl_xor(s2, 32);
                if (fq == 0) part[wc * 256 + rowl] = make_float2(s1, s2);
            }
        __syncthreads();
        unsigned long long* xch = (unsigned long long*)p.xch + (size_t)u.pm * 1024;
        if (t_ < 256) { const float2 a = part[t_], b2 = part[256 + t_], c2 = part[512 + t_], d2 = part[768 + t_];
            const float S1 = (a.x + b2.x) + (c2.x + d2.x), S2 = (a.y + b2.y) + (c2.y + d2.y);
            __hip_atomic_store(xch + t_ * 4 + u.pn, ((unsigned long long)__float_as_uint(S2) << 32) | __float_as_uint(S1), __ATOMIC_RELAXED, __HIP_MEMORY_SCOPE_AGENT); }
        asm volatile("s_waitcnt vmcnt(0)" ::: "memory"); __syncthreads();
        unsigned* cnt = p.pcnt + (layer * 68 + u.pm) * 16;
        if (t_ == 0) { __hip_atomic_fetch_add(cnt, 1u, __ATOMIC_RELAXED, __HIP_MEMORY_SCOPE_AGENT);
            for (unsigned sp = 0; __hip_atomic_load(cnt, __ATOMIC_RELAXED, __HIP_MEMORY_SCOPE_AGENT) < 4u && sp < (1u << 22); ++sp) __builtin_amdgcn_s_sleep(2); }
        __syncthreads();
        if (t_ < 256) { float S1 = 0.f, S2 = 0.f;
#pragma unroll
            for (int k = 0; k < 4; ++k) { const unsigned long long v = __hip_atomic_load(xch + t_ * 4 + k, __ATOMIC_RELAXED, __HIP_MEMORY_SCOPE_AGENT); S1 += __uint_as_float((unsigned)v); S2 += __uint_as_float((unsigned)(v >> 32)); }
            const float mean = S1 * (1.0f / 1024.0f); tab[t_] = make_float2(mean, rsqrtf(fmaxf(S2 * (1.0f / 1024.0f) - mean * mean, 0.f) + 1e-5f)); }
        __syncthreads();
        const float* lg = p.ln_g + layer * 1024 + u.pn * 256 + wc * 32 + c8; const float* lb = p.ln_b + layer * 1024 + u.pn * 256 + wc * 32 + c8;
#pragma unroll
        for (int bj = 0; bj < 2; ++bj) {
            const f32x4 g0 = *(const f32x4*)(lg + bj * 128), g1 = *(const f32x4*)(lg + bj * 128 + 4), b0 = *(const f32x4*)(lb + bj * 128), b1 = *(const f32x4*)(lb + bj * 128 + 4);
#pragma unroll
            for (int ai = 0; ai < 2; ++ai)
#pragma unroll
                for (int m = 0; m < 4; ++m) {
                    const int rowl = ai * 128 + wr * 64 + m * 16 + fr; const float2 mr = tab[rowl];
                    const size_t mrow = (size_t)b * LP + pp0 + rowl; const size_t ho = ((size_t)(b * SEQ + pp0 + rowl - 256)) * DM + u.pn * 256 + wc * 32 + c8 + bj * 128;
                    const f32x4 o0 = (acc[ai][bj][m][0] - mr.x) * mr.y * g0 + b0, o1 = (acc[ai][bj][m][1] - mr.x) * mr.y * g1 + b1;
                    *(f32x4*)(p.out + ho) = o0; *(f32x4*)(p.out + ho + 4) = o1;
                    u32x4 w; w.x = pk2(o0[0], o0[1]); w.y = pk2(o0[2], o0[3]); w.z = pk2(o1[0], o1[1]); w.w = pk2(o1[2], o1[3]);
                    *(u32x4*)(p.R0 + mrow * 1024 + u.pn * 256 + wc * 32 + c8 + bj * 128) = w;
                }
        }
    }
};
template <class Epi, class Sched, bool ALIGN_EPI = false, bool SP2 = false>
__device__ __forceinline__ void gemm_phase(PG8_LAS unsigned char* lds, const Gemm g, const Sched& S, const Epi& E) {
    const int tid = opaque_tid(), wid = __builtin_amdgcn_readfirstlane(tid >> 6), lane = tid & 63, wr = wid >> 2, wc = wid & 3, fr = lane & 15, fq = lane >> 4;
    const int K = g.K, nt = K / BK;
    unsigned voffA[2], voffB[2];
#pragma unroll
    for (int i = 0; i < 2; ++i) { int R, C; stage_rc(tid * 16 + i * 8192, R, C); const int Rb = Epi::PERM ? ((R & ~31) + perm32(R & 31)) : R;
        voffA[i] = (unsigned)(R * K + C) * 2u; voffB[i] = (unsigned)(Rb * K + C) * 2u; }
    const size_t kstep = (size_t)(BK * 2);
    const size_t hstep = (size_t)HALF * K * 2;
    const size_t tstep = 2 * hstep;
    const unsigned ldsw = (unsigned)wid * 1024u;
    const int aoff = lds_byte(wr * 64 + fr, fq * 8), boff = lds_byte(wc * 32 + fr, fq * 8);
#define PG8_SA(b, h) (((b) * 2 + (h)) * HTB)
#define PG8_SB(b, h) ((4 + (b) * 2 + (h)) * HTB)
#define PG8_STAGE(bufoff, gbase, voff) do { _Pragma("unroll") for (int _i = 0; _i < 2; ++_i) \
        __builtin_amdgcn_global_load_lds((const unsigned*)((const char*)(gbase) + (voff)[_i]), (PG8_LAS unsigned*)(lds + (bufoff) + ldsw + _i * 8192), 16, 0, 0); } while (0)
#define PG8_LDA(dst, b, h) do { _Pragma("unroll") for (int m = 0; m < 4; ++m) _Pragma("unroll") for (int k = 0; k < 2; ++k) dst[m][k] = *(const PG8_LAS bf16x8*)(lds + PG8_SA(b, h) + aoff + m * 2048 + k * 1024); } while (0)
#define PG8_LDB(dst, b, h) do { _Pragma("unroll") for (int n = 0; n < 2; ++n) _Pragma("unroll") for (int k = 0; k < 2; ++k) dst[n][k] = *(const PG8_LAS bf16x8*)(lds + PG8_SB(b, h) + boff + n * 2048 + k * 1024); } while (0)
#define PG8_MMA(ai, bj, At, Bt) do { __builtin_amdgcn_s_setprio(1); _Pragma("unroll") for (int m = 0; m < 4; ++m) _Pragma("unroll") for (int n = 0; n < 2; ++n) _Pragma("unroll") for (int k = 0; k < 2; ++k) \
        acc[ai][bj][m][n] = __builtin_amdgcn_mfma_f32_16x16x32_bf16(Bt[n][k], At[m][k], acc[ai][bj][m][n], 0, 0, 0); __builtin_amdgcn_s_setprio(0); } while (0)
#define PG8_WAIT_V(n) asm volatile("s_waitcnt vmcnt(" #n ")" ::: "memory")
#define PG8_WAIT_L(n) asm volatile("s_waitcnt lgkmcnt(" #n ")" ::: "memory")
#define PG8_BAR __builtin_amdgcn_s_barrier()
#define PG8_SCHED __builtin_amdgcn_sched_barrier(0)
    Unit cur, nxt; int ui = 0;
    if (!S.next(0, cur)) return;
    f32x4 acc[2][2][4][2];
#pragma unroll
    for (int a = 0; a < 2; ++a)
#pragma unroll
        for (int b = 0; b < 2; ++b)
#pragma unroll
            for (int m = 0; m < 4; ++m)
#pragma unroll
                for (int n = 0; n < 2; ++n) acc[a][b][m][n] = (f32x4){0.f, 0.f, 0.f, 0.f};
    bf16x8 At[4][2], B0[2][2], B1[2][2];
    const char* cA = (const char*)g.A + (size_t)cur.pm * tstep; const char* cB = (const char*)g.Bt + (size_t)cur.pn * tstep;
    S.a_ready(cur);
    if constexpr (SP2) {
        PG8_STAGE(PG8_SB(0, 0), cB, voffB); PG8_STAGE(PG8_SB(0, 1), cB + hstep, voffB); PG8_STAGE(PG8_SA(0, 0), cA, voffA); PG8_STAGE(PG8_SA(0, 1), cA + hstep, voffA);
        if (wr == 1) PG8_BAR;
        PG8_WAIT_V(2); PG8_BAR;
        PG8_STAGE(PG8_SB(1, 0), cB + kstep, voffB); PG8_STAGE(PG8_SA(1, 0), cA + kstep, voffA); PG8_STAGE(PG8_SB(1, 1), cB + hstep + kstep, voffB);
        PG8_WAIT_V(6); PG8_BAR;
    } else {
        PG8_STAGE(PG8_SB(0, 0), cB, voffB); PG8_STAGE(PG8_SA(0, 0), cA, voffA); PG8_STAGE(PG8_SB(0, 1), cB + hstep, voffB); PG8_STAGE(PG8_SA(0, 1), cA + hstep, voffA);
        if (wr == 1) PG8_BAR;
        PG8_WAIT_V(4); PG8_BAR;
        PG8_STAGE(PG8_SB(1, 0), cB + kstep, voffB); PG8_STAGE(PG8_SA(1, 0), cA + kstep, voffA); PG8_STAGE(PG8_SB(1, 1), cB + hstep + kstep, voffB);
        PG8_WAIT_V(6); PG8_BAR;
    }
    for (;;) {
        const bool has_next = S.next(ui + 1, nxt);
        const char* nA = has_next ? (const char*)g.A + (size_t)nxt.pm * tstep : cA; const char* nB = has_next ? (const char*)g.Bt + (size_t)nxt.pn * tstep : cB;
        for (int t = 0; t < nt; t += 2) {
            const bool last = (t == nt - 2);
            const char* a1 = cA + (size_t)(t + 1) * kstep;
            const char* a2 = last ? nA : cA + (size_t)(t + 2) * kstep; const char* b2 = last ? nB : cB + (size_t)(t + 2) * kstep;
            const char* a3 = a2 + kstep; const char* b3 = b2 + kstep;
            if (last && has_next) S.a_ready(nxt);
            if constexpr (SP2) {
            PG8_LDB(B0, 0, 0); PG8_LDB(B1, 0, 1); PG8_SCHED; PG8_LDA(At, 0, 0); PG8_STAGE(PG8_SA(1, 1), a1 + hstep, voffA);
            PG8_WAIT_V(8); PG8_WAIT_L(0); PG8_BAR; PG8_MMA(0, 0, At, B0); PG8_MMA(0, 1, At, B1); PG8_BAR; PG8_SCHED;
            PG8_LDA(At, 0, 1); PG8_STAGE(PG8_SB(0, 0), b2, voffB); PG8_STAGE(PG8_SB(0, 1), b2 + hstep, voffB); PG8_STAGE(PG8_SA(0, 0), a2, voffA);
            PG8_WAIT_V(8); PG8_WAIT_L(0); PG8_BAR; PG8_MMA(1, 0, At, B0); PG8_MMA(1, 1, At, B1); PG8_BAR; PG8_SCHED;
            PG8_LDB(B0, 1, 0); PG8_LDB(B1, 1, 1); PG8_SCHED; PG8_LDA(At, 1, 0); PG8_STAGE(PG8_SA(0, 1), a2 + hstep, voffA);
            PG8_WAIT_V(8); PG8_WAIT_L(0); PG8_BAR; PG8_MMA(0, 0, At, B0); PG8_MMA(0, 1, At, B1); PG8_BAR; PG8_SCHED;
            PG8_LDA(At, 1, 1); PG8_STAGE(PG8_SB(1, 0), b3, voffB); PG8_STAGE(PG8_SB(1, 1), b3 + hstep, voffB); PG8_STAGE(PG8_SA(1, 0), a3, voffA);
            PG8_WAIT_V(8); PG8_WAIT_L(0); PG8_BAR; PG8_MMA(1, 0, At, B0); PG8_MMA(1, 1, At, B1); PG8_BAR; PG8_SCHED;
            } else {
            PG8_LDB(B0, 0, 0); PG8_SCHED; PG8_LDA(At, 0, 0); PG8_STAGE(PG8_SA(1, 1), a1 + hstep, voffA);
            PG8_WAIT_L(8); PG8_BAR; PG8_WAIT_L(0); PG8_MMA(0, 0, At, B0); PG8_BAR; PG8_SCHED;
            PG8_LDB(B1, 0, 1); PG8_STAGE(PG8_SB(0, 0), b2, voffB);
            PG8_BAR; PG8_WAIT_L(0); PG8_MMA(0, 1, At, B1); PG8_BAR;
            PG8_LDA(At, 0, 1); PG8_STAGE(PG8_SA(0, 0), a2, voffA);
            PG8_BAR; PG8_WAIT_L(0); PG8_MMA(1, 0, At, B0); PG8_BAR; PG8_SCHED;
            PG8_STAGE(PG8_SB(0, 1), b2 + hstep, voffB);
            PG8_WAIT_V(6); PG8_BAR; PG8_MMA(1, 1, At, B1); PG8_BAR;
            PG8_LDB(B0, 1, 0); PG8_SCHED; PG8_LDA(At, 1, 0); PG8_STAGE(PG8_SA(0, 1), a2 + hstep, voffA);
            PG8_WAIT_L(8); PG8_BAR; PG8_WAIT_L(0); PG8_MMA(0, 0, At, B0); PG8_BAR; PG8_SCHED;
            PG8_LDB(B1, 1, 1); PG8_STAGE(PG8_SB(1, 0), b3, voffB);
            PG8_BAR; PG8_WAIT_L(0); PG8_MMA(0, 1, At, B1); PG8_BAR;
            PG8_LDA(At, 1, 1); PG8_STAGE(PG8_SA(1, 0), a3, voffA);
            PG8_BAR; PG8_WAIT_L(0); PG8_MMA(1, 0, At, B0); PG8_BAR; PG8_SCHED;
            PG8_STAGE(PG8_SB(1, 1), b3 + hstep, voffB);
            PG8_WAIT_V(6); PG8_BAR; PG8_MMA(1, 1, At, B1); PG8_BAR;
            }
        }
        if constexpr (ALIGN_EPI) { if (wr == 0) PG8_BAR; }
        if constexpr (!Epi::AFTER_DRAIN) { E(acc, cur, wr, wc, fr, fq); S.done(cur); }
        if (!has_next) break;
#pragma unroll
        for (int a = 0; a < 2; ++a)
#pragma unroll
            for (int b = 0; b < 2; ++b)
#pragma unroll
                for (int m = 0; m < 4; ++m)
#pragma unroll
                    for (int n = 0; n < 2; ++n) acc[a][b][m][n] = (f32x4){0.f, 0.f, 0.f, 0.f};
        cur = nxt; cA = nA; cB = nB; ++ui;
        if constexpr (ALIGN_EPI) { if (wr == 1) PG8_BAR; }
    }
    PG8_WAIT_V(0);
    if constexpr (!ALIGN_EPI) { if (wr == 0) PG8_BAR; }
    PG8_BAR;
    if constexpr (Epi::AFTER_DRAIN) { E.fused(acc, cur, wr, wc, fr, fq, lds, wid, lane); S.done(cur); }
#undef PG8_SA
#undef PG8_SB
#undef PG8_STAGE
#undef PG8_LDA
#undef PG8_LDB
#undef PG8_MMA
#undef PG8_WAIT_V
#undef PG8_WAIT_L
#undef PG8_BAR
#undef PG8_SCHED
}
}

constexpr int META_LD = 2064;
DI void meta_gemm(const Params& p, int sub, int j, int layer, char* smem) {
  const int tid = opaque_tid(), lane = tid & 63, nl = tid >> 6;
  const bf16_t* A; const bf16_t* W; int K, N;
  if (sub == 0) { A = p.R0; K = 1024; N = 4096; W = p.W_evin + (size_t)j * 4096 * 1024; }
  else if (sub == 1) { A = p.R0; K = 1024; N = 1856; W = p.W_odin + (size_t)j * 2048 * 1024; }
  else if (sub == 2) { A = p.R3; K = 512; N = 1536; W = p.W_oduq + (size_t)j * 1536 * 512; }
  else if (sub == 3) { A = p.R3 + (size_t)MP * 512; K = 256; N = 2048; W = p.W_odukv + (size_t)j * 2048 * 256; }
  else { A = (layer & 1) ? p.R3 : p.R0; K = 1024; N = 1024; W = ((layer & 1) ? p.W_odout : p.W_evout) + (size_t)j * 1024 * 1024; }
  const int kch = K >> 3;
  if (sub <= 1 && layer > 0) {
    const int wv = tid >> 6; const float* lg = p.ln_g + (layer - 1) * 1024; const float* lb = p.ln_b + (layer - 1) * 1024;
    for (int row = wv; row < 64; row += 8) {
      const float* zr = p.hmeta + ((size_t)((row >> 4) * 64 + (row & 15))) * DM; float* hr = p.hmeta + ((size_t)((row >> 4) * 64 + 48 + (row & 15))) * DM;
      float4 z[4]; float s1 = 0.f;
#pragma unroll
      for (int i = 0; i < 4; ++i) { z[i] = *(const float4*)(zr + 256 * i + 4 * lane); s1 += (z[i].x + z[i].y) + (z[i].z + z[i].w); }
      const float mean = wave_sum(s1) * (1.0f / 1024.0f); float s2 = 0.f;
#pragma unroll
      for (int i = 0; i < 4; ++i) { const float a = z[i].x - mean, b2 = z[i].y - mean, c2 = z[i].z - mean, d2 = z[i].w - mean; s2 += (a * a + b2 * b2) + (c2 * c2 + d2 * d2); }
      const float rstd = rsqrtf(wave_sum(s2) * (1.0f / 1024.0f) + 1e-5f);
#pragma unroll
      for (int i = 0; i < 4; ++i) { const int n = 256 * i + 4 * lane; const float4 g = *(const float4*)(lg + n), bb = *(const float4*)(lb + n);
        float4 o; o.x = (z[i].x - mean) * rstd * g.x + bb.x; o.y = (z[i].y - mean) * rstd * g.y + bb.y; o.z = (z[i].z - mean) * rstd * g.z + bb.z; o.w = (z[i].w - mean) * rstd * g.w + bb.w;
        *(uint2*)(smem + row * META_LD + n * 2) = pk4(o.x, o.y, o.z, o.w);
        if (blockIdx.x == 0) *(float4*)(hr + n) = o; }
    }
  } else {
    for (int c = tid; c < 64 * kch; c += NTHR) { const int row = c / kch, kc = c % kch; const size_t m = (size_t)(row >> 4) * LP + OFF + (row & 15);
      *(uint4*)(smem + row * META_LD + kc * 16) = *(const uint4*)(A + m * K + kc * 8); }
  }
  __syncthreads();
  const int b = lane >> 4, pp = OFF + (lane & 15); const size_t m = (size_t)b * LP + pp;
  const char* ar = smem + lane * META_LD;
  float rs = 1.0f;
  if (sub == 2 || sub == 3) { float ss = 0.f; for (int kc = 0; kc < kch; ++kc) { const uint4 v = *(const uint4*)(ar + kc * 16);
      ss += lo16(v.x) * lo16(v.x) + hi16(v.x) * hi16(v.x) + lo16(v.y) * lo16(v.y) + hi16(v.y) * hi16(v.y) + lo16(v.z) * lo16(v.z) + hi16(v.z) * hi16(v.z) + lo16(v.w) * lo16(v.w) + hi16(v.w) * hi16(v.w); }
    rs = rsqrtf(ss / (float)K + 1e-6f); }
  for (int n0 = blockIdx.x * 8; n0 < N; n0 += gridDim.x * 8) {
    const int n = n0 + nl;
    if (n < N) {
      const bf16_t* wrow = W + (size_t)n * K; float acc = 0.f;
      for (int kc = 0; kc < kch; ++kc) { const uint4 av = *(const uint4*)(ar + kc * 16), wv = *(const uint4*)(wrow + kc * 8);
        acc += lo16(av.x) * lo16(wv.x) + hi16(av.x) * hi16(wv.x) + lo16(av.y) * lo16(wv.y) + hi16(av.y) * hi16(wv.y) + lo16(av.z) * lo16(wv.z) + hi16(av.z) * hi16(wv.z) + lo16(av.w) * lo16(wv.w) + hi16(av.w) * hi16(wv.w); }
      const float v = acc * rs;
      if (sub == 0) { if (n < 3072) p.R2[m * 3072 + n] = f2bf(v); else p.R1[((size_t)b * 1024 + n - 3072) * LP + pp] = f2bf(v); }
      else if (sub == 1) { if (n < 512) p.R3[m * 512 + n] = f2bf(v); else if (n < 768) p.R3[(size_t)MP * 512 + m * 256 + n - 512] = f2bf(v);
                           else if (n < 1792) p.R2[m * 1024 + n - 768] = f2bf(v); else p.R2[(size_t)MP * 2624 + m * 64 + n - 1792] = f2bf(v); }
      else if (sub == 2) p.R2[(size_t)MP * 1024 + m * 1536 + n] = f2bf(v);
      else if (sub == 3) { if (n < 1024) p.R0[m * 1024 + n] = f2bf(v); else p.R1[((size_t)b * 1024 + n - 1024) * LP + pp] = f2bf(v); }
      else p.hmeta[((size_t)(b * 64 + (lane & 15))) * DM + n] = ALPHA * hrow(p, b, pp)[n] + v;
    }
  }
  __syncthreads();
}
DI void kpe_rope_pass(const Params& p) {
  const bf16_t* raw = p.R2 + (size_t)MP * 2624; bf16_t* dst = p.R2 + (size_t)MP * 2560;
  const size_t gt = (size_t)blockIdx.x * NTHR + opaque_tid(), gs = (size_t)gridDim.x * NTHR;
  for (size_t i = gt; i < (size_t)NB * 4112 * 4; i += gs) { const int rr = (int)(i >> 2), f8 = (int)(i & 3) * 8; const int b = rr / 4112, pp = OFF + rr % 4112; const size_t m = (size_t)b * LP + pp;
    const uint4 lo = *(const uint4*)(raw + m * 64 + f8), hi = *(const uint4*)(raw + m * 64 + 32 + f8);
    const float* rp = p.rope + (size_t)pp * 64 + f8;
    const float4 c0 = *(const float4*)rp, c1 = *(const float4*)(rp + 4), s0 = *(const float4*)(rp + 32), s1 = *(const float4*)(rp + 36);
    const float cc[8] = {c0.x, c0.y, c0.z, c0.w, c1.x, c1.y, c1.z, c1.w}, sn[8] = {s0.x, s0.y, s0.z, s0.w, s1.x, s1.y, s1.z, s1.w};
    const unsigned lw[4] = {lo.x, lo.y, lo.z, lo.w}, hw[4] = {hi.x, hi.y, hi.z, hi.w};
    unsigned ol[4], oh[4];
#pragma unroll
    for (int q = 0; q < 4; ++q) {
      const float x1a = lo16(lw[q]), x1b = hi16(lw[q]), x2a = lo16(hw[q]), x2b = hi16(hw[q]);
      ol[q] = (unsigned)f2bf(x1a * cc[2 * q] - x2a * sn[2 * q]) | ((unsigned)f2bf(x1b * cc[2 * q + 1] - x2b * sn[2 * q + 1]) << 16);
      oh[q] = (unsigned)f2bf(x2a * cc[2 * q] + x1a * sn[2 * q]) | ((unsigned)f2bf(x2b * cc[2 * q + 1] + x1b * sn[2 * q + 1]) << 16);
    }
    *(uint4*)(dst + m * 64 + f8) = make_uint4(ol[0], ol[1], ol[2], ol[3]); *(uint4*)(dst + m * 64 + 32 + f8) = make_uint4(oh[0], oh[1], oh[2], oh[3]); }
}
DI void gemm_phase(const Params& p, int mode, int j, int layer, char* smem) {
  PG8_LAS unsigned char* lds = (PG8_LAS unsigned char*)smem;
  const int G = gridDim.x;
  const int c = __builtin_amdgcn_readfirstlane(((const int*)(smem + SM_SLOT + 256))[2]);
  if (mode == 0) {
    meta_gemm(p, 0, j, layer, smem);
#ifdef METAREP
    meta_gemm(p, 0, j, layer, smem);
#endif
    pg8::Gemm g{p.R0, p.W_evin + (size_t)j * 4096 * 1024, MP, 4096, 1024}; pg8::FrameOrder S; S.init(16, G, c); pg8::EpiMix<0> E{&p, 0};
    pg8::gemm_phase<pg8::EpiMix<0>, pg8::FrameOrder, true, true>(lds, g, S, E);
  } else if (mode == 1) {
    meta_gemm(p, 1, j, layer, smem);
    pg8::Gemm g{p.R0, p.W_odin + (size_t)j * 2048 * 1024, MP, 2048, 1024}; pg8::FrameOrder S; S.init(8, G, c); pg8::EpiMix<1> E{&p, 0};
    pg8::gemm_phase<pg8::EpiMix<1>, pg8::FrameOrder, true, true>(lds, g, S, E);
  } else if (mode == 2) {
    kpe_rope_pass(p);
    meta_gemm(p, 2, j, layer, smem); meta_gemm(p, 3, j, layer, smem);
    const bool lo = c < (G >> 1);
    const pg8::ListOrder Sq{lo ? 2 : 1, c, G, 6}, Skv{lo ? 1 : 3, lo ? c : (G >> 1) + (c - (G >> 1)) * 3, 1, 8};
    {
      const int t = opaque_tid();
      if (t < 256) {
        pg8::Unit u;
        for (int i = 0; Sq.next(i, u); ++i) { const size_t mrow = (size_t)(u.pm / 17) * LP + (u.pm % 17) * 256 + t; const float4* q = (const float4*)(p.rowss + mrow * 24); float a = 0.f;
          for (int k = 0; k < 4; ++k) { const float4 x = q[k]; a += (x.x + x.y) + (x.z + x.w); }
          p.rsarr[mrow * 2] = rsqrtf(a * (1.0f / 512.0f) + 1e-6f); }
        for (int i = 0; Skv.next(i, u); ++i) { const size_t mrow = (size_t)(u.pm / 17) * LP + (u.pm % 17) * 256 + t; const float4* q = (const float4*)(p.rowss + mrow * 24 + 16); float a = 0.f;
          for (int k = 0; k < 2; ++k) { const float4 x = q[k]; a += (x.x + x.y) + (x.z + x.w); }
          p.rsarr[mrow * 2 + 1] = rsqrtf(a * (1.0f / 256.0f) + 1e-6f); }
      }
      __threadfence_block(); __syncthreads();
    }
    { pg8::Gemm g{p.R3, p.W_oduq + (size_t)j * 1536 * 512, MP, 1536, 512}; pg8::EpiMix<2> E{&p, 0};
      pg8::gemm_phase<pg8::EpiMix<2>, pg8::ListOrder, true, true>(lds, g, Sq, E); }
    { pg8::Gemm g{p.R3 + (size_t)MP * 512, p.W_odukv + (size_t)j * 2048 * 256, MP, 2048, 256}; pg8::EpiMix<3> E{&p, 0};
      pg8::gemm_phase<pg8::EpiMix<3>, pg8::ListOrder, true, true>(lds, g, Skv, E); }
  } else {
    meta_gemm(p, 4, j, layer, smem);
    pg8::Gemm g{(layer & 1) ? p.R3 : p.R0, ((layer & 1) ? p.W_odout : p.W_evout) + (size_t)j * 1024 * 1024, MP, 1024, 1024}; pg8::FrameOrder S; S.init(4, G, c); pg8::EpiOutLn E{&p, layer == 0, layer};
    pg8::gemm_phase<pg8::EpiOutLn, pg8::FrameOrder, false, true>(lds, g, S, E);
  }
}

DI void norm_phase(const Params& p, int layer, char* smem) {
  const int tid = opaque_tid(), lane = tid & 63;
  const float* lg = p.ln_g + layer * 1024; const float* lb = p.ln_b + layer * 1024;
  const int gw = blockIdx.x * 8 + (tid >> 6), nw = gridDim.x * 8;
  for (int row = gw; row < NB * 4112; row += nw) {
    const int b = row / 4112, pp = OFF + row % 4112; const size_t m = (size_t)b * LP + pp;
    float* hr = hrow(p, b, pp);
    float4 z[4]; float s1 = 0.f;
#pragma unroll
    for (int i = 0; i < 4; ++i) { z[i] = *(const float4*)(hr + 256 * i + 4 * lane); s1 += (z[i].x + z[i].y) + (z[i].z + z[i].w); }
    const float mean = wave_sum(s1) * (1.0f / 1024.0f);
    float s2 = 0.f;
#pragma unroll
    for (int i = 0; i < 4; ++i) { const float a = z[i].x - mean, bq = z[i].y - mean, cq = z[i].z - mean, d = z[i].w - mean; s2 += (a * a + bq * bq) + (cq * cq + d * d); }
    const float rstd = rsqrtf(wave_sum(s2) * (1.0f / 1024.0f) + 1e-5f);
#pragma unroll
    for (int i = 0; i < 4; ++i) { const int n = 256 * i + 4 * lane; const float4 g = *(const float4*)(lg + n), bb = *(const float4*)(lb + n);
      float4 o; o.x = (z[i].x - mean) * rstd * g.x + bb.x; o.y = (z[i].y - mean) * rstd * g.y + bb.y; o.z = (z[i].z - mean) * rstd * g.z + bb.z; o.w = (z[i].w - mean) * rstd * g.w + bb.w;
      *(float4*)(hr + n) = o; *(uint2*)(p.R0 + m * 1024 + n) = pk4(o.x, o.y, o.z, o.w); }
  }
}

DI int next_item(unsigned* ctr, char* smem) {
  int* slot = (int*)(smem + SM_SLOT);
  __syncthreads();
  if (opaque_tid() == 0) *slot = (int)atomicAdd(ctr, 1u);
  __syncthreads();
  return *slot;
}
constexpr int M_KSZ = 25600, M_STAGE = 25600 + 17408;
DI void mla_item(const Params& p, int b, int head, int T, char* smem) {
  const int tid = opaque_tid(), w = tid >> 6, lane = tid & 63, r = lane & 31, hh = lane >> 5;
  const int q0 = T * 256, qw = q0 + 32 * w; const bool wact = qw >= 192; const int jq = qw >> 6; const int jtop = (q0 >> 6) + 3;
  const bf16_t* Q = p.R2 + (size_t)MP * 1024; const bf16_t* KP = p.R2 + (size_t)MP * 2560;
  const size_t mq = (size_t)b * LP + qw + r;
  bf16x8 qf[12];
#pragma unroll
  for (int s = 0; s < 12; ++s) qf[s] = *(const bf16x8*)(Q + mq * 1536 + 192 * head + 16 * s + 8 * hh);
  {
    const float* rp = p.rope + (size_t)(qw + r) * 64 + 8 * hh;
#pragma unroll
    for (int s = 8; s < 10; ++s) {
      const float4 ca = *(const float4*)(rp + 16 * (s - 8)), cb = *(const float4*)(rp + 16 * (s - 8) + 4), sa = *(const float4*)(rp + 32 + 16 * (s - 8)), sb = *(const float4*)(rp + 32 + 16 * (s - 8) + 4);
      const float cc[8] = {ca.x, ca.y, ca.z, ca.w, cb.x, cb.y, cb.z, cb.w}, sn[8] = {sa.x, sa.y, sa.z, sa.w, sb.x, sb.y, sb.z, sb.w};
      float y1[8], y2[8];
#pragma unroll
      for (int jj = 0; jj < 8; ++jj) { const float x1 = bf2f((bf16_t)qf[s][jj]), x2 = bf2f((bf16_t)qf[s + 2][jj]); y1[jj] = x1 * cc[jj] - x2 * sn[jj]; y2[jj] = x2 * cc[jj] + x1 * sn[jj]; }
      uint4 u1, u2; u1.x = pk2(y1[0], y1[1]); u1.y = pk2(y1[2], y1[3]); u1.z = pk2(y1[4], y1[5]); u1.w = pk2(y1[6], y1[7]);
      u2.x = pk2(y2[0], y2[1]); u2.y = pk2(y2[2], y2[3]); u2.z = pk2(y2[4], y2[5]); u2.w = pk2(y2[6], y2[7]);
      qf[s] = __builtin_bit_cast(bf16x8, u1); qf[s + 2] = __builtin_bit_cast(bf16x8, u2);
    }
  }
  f32x16 O[4];
#pragma unroll
  for (int d = 0; d < 4; ++d)
#pragma unroll
    for (int e = 0; e < 16; ++e) O[d][e] = 0.f;
  float mrun = -INFINITY, lrun = 0.f;
  uint4 k0, k1, k2, v0, v1;
  const int kr = tid >> 3, kc = tid & 7;
  const int vd = tid >> 3, vkc = tid & 7;
  auto ldv = [&](int jt, int i) -> uint4 { return *(const uint4*)(p.R1 + ((size_t)b * 1024 + 128 * head + vd + 64 * i) * LP + 64 * jt + vkc * 8); };
  auto stv = [&](char* sb, int i, uint4 v) { char* vp = sb + M_KSZ + (vd + 64 * i) * 136 + vkc * 16; *(uint2*)vp = make_uint2(v.x, v.y); *(uint2*)(vp + 8) = make_uint2(v.z, v.w); };
#define A_LOAD(jt) { const size_t mk = (size_t)b * LP + 64 * (jt) + kr; const bf16_t* kn = p.R0 + mk * 1024 + 128 * head + kc * 8; \
                     k0 = *(const uint4*)kn; k1 = *(const uint4*)(kn + 64); k2 = *(const uint4*)(KP + mk * 64 + kc * 8); v0 = ldv(jt, 0); v1 = ldv(jt, 1); }
#define A_STORE(st) { char* sb = smem + (st) * M_STAGE; char* kp_ = sb + kr * 400 + kc * 16; *(uint4*)kp_ = k0; *(uint4*)(kp_ + 128) = k1; *(uint4*)(kp_ + 256) = k2; stv(sb, 0, v0); stv(sb, 1, v1); }
  A_LOAD(3); A_STORE(0);
  __syncthreads();
  for (int jt = 3; jt <= jtop; ++jt) {
    const int cur = (jt - 3) & 1;
    const bool act = wact && jt <= jq;
    f32x16 st[2];
    if (act) {
      const char* kb_ = smem + cur * M_STAGE + r * 400 + hh * 16;
#pragma unroll
      for (int e = 0; e < 16; ++e) { st[0][e] = 0.f; st[1][e] = 0.f; }
      {
        bf16x8 f[2][2][2];
#pragma unroll
        for (int i = 0; i < 2; ++i) { f[0][0][i] = ld_frag(kb_ + i * 32); f[0][1][i] = ld_frag(kb_ + 32 * 400 + i * 32); }
#pragma unroll
        for (int bt = 0; bt < 6; ++bt) {
          if (bt < 5) {
#pragma unroll
            for (int i = 0; i < 2; ++i) { f[(bt + 1) & 1][0][i] = ld_frag(kb_ + (2 * bt + 2 + i) * 32); f[(bt + 1) & 1][1][i] = ld_frag(kb_ + 32 * 400 + (2 * bt + 2 + i) * 32); }
          }
          __builtin_amdgcn_sched_barrier(0);
#pragma unroll
          for (int i = 0; i < 2; ++i) { st[0] = MFMA32(f[bt & 1][0][i], qf[2 * bt + i], st[0]); st[1] = MFMA32(f[bt & 1][1][i], qf[2 * bt + i], st[1]); }
          __builtin_amdgcn_sched_barrier(0);
        }
      }
    }
    if (jt < jtop) { A_LOAD(jt + 1); }
    if (act) {
      if (jt == 3) {
#pragma unroll
        for (int e = 0; e < 16; ++e) st[0][e] = -INFINITY;
#pragma unroll
        for (int e = 0; e < 8; ++e) st[1][e] = -INFINITY;
      }
      float mx = st[0][0];
#pragma unroll
      for (int e = 1; e < 16; ++e) mx = fmaxf(mx, st[0][e]);
#pragma unroll
      for (int e = 0; e < 16; ++e) mx = fmaxf(mx, st[1][e]);
      mx = x32_max(mx);
      if (!__builtin_expect(__all(mx - mrun <= 6.0f), 1)) {
        const float mnew = fmaxf(mrun, mx); const float alpha = ex2(mrun - mnew); mrun = mnew; lrun *= alpha;
#pragma unroll
        for (int d = 0; d < 4; ++d)
#pragma unroll
          for (int e = 0; e < 16; ++e) O[d][e] *= alpha;
      }
      float rsum = 0.f;
#pragma unroll
      for (int kb = 0; kb < 2; ++kb)
#pragma unroll
        for (int e = 0; e < 16; ++e) { const float pv = ex2(st[kb][e] - mrun); st[kb][e] = pv; rsum += pv; }
      lrun += rsum;
      const char* vb_ = smem + cur * M_STAGE + M_KSZ + r * 136 + hh * 8;
#pragma unroll
      for (int kb = 0; kb < 2; ++kb)
#pragma unroll
        for (int s2 = 0; s2 < 2; ++s2) { const bf16x8 pf = pack_step(st[kb], s2);
#pragma unroll
          for (int d = 0; d < 4; ++d) O[d] = MFMA32(ld_vfrag(vb_ + d * 32 * 136 + (32 * kb + 16 * s2) * 2), pf, O[d]); }
    }
    if (jt < jtop) { A_STORE(cur ^ 1); }
    __syncthreads();
  }
#undef A_LOAD
#undef A_STORE
  if (wact) {
    const float l = x32_sum(lrun); const float inv = 1.0f / l;
    const bf16_t* G = p.R2 + mq * 1024 + 128 * head; bf16_t* Yp = p.R3 + mq * 1024 + 128 * head;
#pragma unroll
    for (int d = 0; d < 4; ++d)
#pragma unroll
      for (int gp = 0; gp < 2; ++gp) { uint2 ab[2];
#pragma unroll
        for (int k = 0; k < 2; ++k) { const int g = 2 * gp + k; const int dd = 32 * d + 8 * g + 4 * hh; const uint2 gv = *(const uint2*)(G + dd);
          ab[k] = pk4(O[d][4 * g] * inv * silu_f(lo16(gv.x)), O[d][4 * g + 1] * inv * silu_f(hi16(gv.x)), O[d][4 * g + 2] * inv * silu_f(lo16(gv.y)), O[d][4 * g + 3] * inv * silu_f(hi16(gv.y))); }
        store_pair16(Yp, 32 * d + 16 * gp, hh, ab[0], ab[1]); }
  }
}
DI void mla_phase(const Params& p, int layer, char* smem) {
  for (;;) { const int id = next_item(p.ctr + layer, smem); if (id >= 17 * 32) break;
    const int T = 16 - id / 32, u = id % 32; mla_item(p, u >> 3, u & 7, T, smem); }
}
constexpr int D_KSZ = 17408, D_STAGE = 34816;
DI void diff_item(const Params& p, int j, int b, int head, int t, char* smem) {
  const int tid = opaque_tid(), w = tid >> 6, lane = tid & 63, r = lane & 31, hh = lane >> 5, map = w >> 2;
  const int q0 = t * 128, qw = q0 + 32 * (w & 3); const bool wact = qw >= 192; const int jq = qw >> 6; const int jtop = (q0 >> 6) + 1;
  const size_t mq = (size_t)b * LP + qw + r;
  bf16x8 qf[4];
#pragma unroll
  for (int s = 0; s < 4; ++s) qf[s] = *(const bf16x8*)(p.R2 + mq * 3072 + 128 * head + 64 * map + 16 * s + 8 * hh);
  f32x16 O[4];
#pragma unroll
  for (int d = 0; d < 4; ++d)
#pragma unroll
    for (int e = 0; e < 16; ++e) O[d][e] = 0.f;
  float mrun = -INFINITY, lrun = 0.f;
  const float sl2 = ex2(-2.0f * (float)(head + 1)) * LOG2E;
  uint4 k0, k1, v0, v1;
  const int krow = tid >> 4, kkc = tid & 15, vd = tid >> 3, vkc = tid & 7;
  auto ldk = [&](int jt, int i) -> uint4 { return *(const uint4*)(p.R2 + ((size_t)b * LP + 64 * jt + krow + 32 * i) * 3072 + 512 + 128 * head + kkc * 8); };
  auto ldv = [&](int jt, int i) -> uint4 { return *(const uint4*)(p.R1 + ((size_t)b * 1024 + 128 * head + vd + 64 * i) * LP + 64 * jt + vkc * 8); };
  auto stv = [&](char* sb, int i, uint4 v) { char* vp = sb + D_KSZ + (vd + 64 * i) * 136 + vkc * 16; *(uint2*)vp = make_uint2(v.x, v.y); *(uint2*)(vp + 8) = make_uint2(v.z, v.w); };
#define A_LOAD(jt) { k0 = ldk(jt, 0); k1 = ldk(jt, 1); v0 = ldv(jt, 0); v1 = ldv(jt, 1); }
#define A_STORE(st) { char* sb = smem + (st) * D_STAGE; *(uint4*)(sb + krow * 272 + kkc * 16) = k0; *(uint4*)(sb + (krow + 32) * 272 + kkc * 16) = k1; stv(sb, 0, v0); stv(sb, 1, v1); }
  const bool skp = head < 2;
  float bq = 0.f;
  if (skp) {
    float* red = (float*)(smem + SM_SLOT + 128);
    float m0 = 0.f, m1 = 0.f;
    for (int row = 256 + tid; row < q0 + 128; row += NTHR) { const float4 v = *(const float4*)(p.rowss + ((size_t)b * LP + row) * 24 + 4 * head); m0 = fmaxf(m0, v.x + v.y); m1 = fmaxf(m1, v.z + v.w); }
    m0 = wave_max(m0); m1 = wave_max(m1);
    if (lane == 0) { red[w] = m0; red[8 + w] = m1; }
    __syncthreads();
    float km = 0.f;
#pragma unroll
    for (int i = 0; i < 8; ++i) km = fmaxf(km, red[8 * map + i]);
    float qn = 0.f;
#pragma unroll
    for (int s_ = 0; s_ < 4; ++s_)
#pragma unroll
      for (int jj = 0; jj < 8; ++jj) { const float x = bf2f((bf16_t)qf[s_][jj]); qn += x * x; }
    qn = x32_sum(qn);
    bq = sqrtf(qn * km) * 1.01f + 0.01f;
  }
  bool wdone = false;
  int jt = jtop, cur = 0, step = 0;
  A_LOAD(jtop); A_STORE(0);
  __syncthreads();
  for (;;) {
    const int nj = jt - 1;
    if (nj >= 3) { A_LOAD(nj); }
    if (wact && jt <= jq && !(wdone && jt > 3)) {
      const char* kb_ = smem + cur * D_STAGE + r * 272 + 128 * map + hh * 16;
      f32x16 st[2];
      {
        bf16x8 f0[4], f1[4];
#pragma unroll
        for (int i = 0; i < 4; ++i) { f0[i] = ld_frag(kb_ + i * 32); f1[i] = ld_frag(kb_ + 32 * 272 + i * 32); }
        __builtin_amdgcn_sched_barrier(0);
#pragma unroll
        for (int e = 0; e < 16; ++e) { st[0][e] = 0.f; st[1][e] = 0.f; }
#pragma unroll
        for (int i = 0; i < 4; ++i) { st[0] = MFMA32(f0[i], qf[i], st[0]); st[1] = MFMA32(f1[i], qf[i], st[1]); }
      }
#pragma unroll
      for (int kb = 0; kb < 2; ++kb) {
        const float dq = (float)(qw + r - 64 * jt - 32 * kb - 4 * hh);
#pragma unroll
        for (int e = 0; e < 16; ++e) st[kb][e] -= sl2 * fabsf(dq - (float)((e & 3) + 8 * (e >> 2)));
      }
      if (jt == 3) {
#pragma unroll
        for (int e = 0; e < 16; ++e) st[0][e] = -INFINITY;
#pragma unroll
        for (int e = 0; e < 8; ++e) st[1][e] = -INFINITY;
      }
      float mx = st[0][0];
#pragma unroll
      for (int e = 1; e < 16; ++e) mx = fmaxf(mx, st[0][e]);
#pragma unroll
      for (int e = 0; e < 16; ++e) mx = fmaxf(mx, st[1][e]);
      mx = x32_max(mx);
      if (!__builtin_expect(__all(mx - mrun <= 6.0f), 1)) {
        const float mnew = fmaxf(mrun, mx); const float alpha = ex2(mrun - mnew); mrun = mnew; lrun *= alpha;
#pragma unroll
        for (int d = 0; d < 4; ++d)
#pragma unroll
          for (int e = 0; e < 16; ++e) O[d][e] *= alpha;
      }
      float rsum = 0.f;
#pragma unroll
      for (int kb = 0; kb < 2; ++kb)
#pragma unroll
        for (int e = 0; e < 16; ++e) { const float pv = ex2(st[kb][e] - mrun); st[kb][e] = pv; rsum += pv; }
      lrun += rsum;
      const char* vb_ = smem + cur * D_STAGE + D_KSZ + r * 136 + hh * 8;
#pragma unroll
      for (int kb = 0; kb < 2; ++kb)
#pragma unroll
        for (int s2 = 0; s2 < 2; ++s2) { const bf16x8 pf = pack_step(st[kb], s2);
#pragma unroll
          for (int d = 0; d < 4; ++d) O[d] = MFMA32(ld_vfrag(vb_ + d * 32 * 136 + (32 * kb + 16 * s2) * 2), pf, O[d]); }
      if (skp) wdone = !__any(bq - sl2 * (float)(qw + r - 64 * nj - 63) - mrun > -150.0f);
    }
    if (nj >= 3) { A_STORE(cur ^ 1); }
    bool alld = false;
    if (skp && nj > 3) {
      int* fl = (int*)(smem + SM_SLOT + 64) + (step & 1) * 8;
      if (lane == 0) fl[w] = ((!wact) || (jt <= jq && wdone)) ? 1 : 0;
      __syncthreads();
      const int4 f0 = *(const int4*)fl, f1 = *(const int4*)(fl + 4);
      alld = (f0.x & f0.y & f0.z & f0.w & f1.x & f1.y & f1.z & f1.w) != 0;
    } else __syncthreads();
    if (nj < 3) break;
    if (alld) { A_LOAD(3); A_STORE(cur); __syncthreads(); jt = 3; }
    else { jt = nj; cur ^= 1; }
    ++step;
  }
#undef A_LOAD
#undef A_STORE
  const float l = x32_sum(lrun); const float inv = wact ? 1.0f / l : 0.f;
  float* ex = (float*)smem + (size_t)(w & 3) * 4096 + lane;
  if (map == 1) {
#pragma unroll
    for (int d = 0; d < 4; ++d)
#pragma unroll
      for (int e = 0; e < 16; ++e) ex[(d * 16 + e) * 64] = O[d][e] * inv;
  }
  __syncthreads();
  if (map == 0 && wact) {
    const float lam = p.lam[2 * j], om = 1.0f - p.lam[2 * j + 1];
    float ss = 0.f;
#pragma unroll
    for (int d = 0; d < 4; ++d)
#pragma unroll
      for (int e = 0; e < 16; ++e) { const float o = O[d][e] * inv - lam * ex[(d * 16 + e) * 64]; O[d][e] = o; ss += o * o; }
    ss = x32_sum(ss);
    const float rr = rsqrtf(ss * (1.0f / 128.0f) + 1e-6f) * om;
    const bf16_t* G = p.R2 + mq * 3072 + 1024 + 128 * head; bf16_t* Yp = p.R0 + mq * 1024 + 128 * head; const float* sg = p.subln + j * 128;
#pragma unroll
    for (int d = 0; d < 4; ++d)
#pragma unroll
      for (int gp = 0; gp < 2; ++gp) { uint2 ab[2];
#pragma unroll
        for (int k = 0; k < 2; ++k) { const int g = 2 * gp + k; const int dd = 32 * d + 8 * g + 4 * hh; const uint2 gv = *(const uint2*)(G + dd); const float4 s4 = *(const float4*)(sg + dd);
          ab[k] = pk4(O[d][4 * g] * rr * s4.x * silu_f(lo16(gv.x)), O[d][4 * g + 1] * rr * s4.y * silu_f(hi16(gv.x)), O[d][4 * g + 2] * rr * s4.z * silu_f(lo16(gv.y)), O[d][4 * g + 3] * rr * s4.w * silu_f(hi16(gv.y))); }
        store_pair16(Yp, 32 * d + 16 * gp, hh, ab[0], ab[1]); }
  }
}
constexpr int S_KSZ = 9216, S_STAGE = 9216 + 8704;
DI void sb_item(const Params& p, int b, int hg, int jq, char* smem) {
  const int tid = opaque_tid(), w = tid >> 6, lane = tid & 63, r = lane & 31, hh = lane >> 5;
  const int head = 4 * hg + (w >> 1); const int qw = 64 * jq + 32 * (w & 1); const bool wact = true; const int jtop = jq;
  const size_t mq = (size_t)b * LP + qw + r; const int qpos = qw + r;
  bf16x8 qf[4];
#pragma unroll
  for (int s = 0; s < 4; ++s) qf[s] = *(const bf16x8*)(p.R2 + mq * 3072 + 1536 + 64 * head + 16 * s + 8 * hh);
  f32x16 O[2];
#pragma unroll
  for (int d = 0; d < 2; ++d)
#pragma unroll
    for (int e = 0; e < 16; ++e) O[d][e] = 0.f;
  float carry = 0.f;
  uint4 k0, k1, k2, k3, v0, v1, v2, v3;
  const int krow = tid >> 3, kkc = tid & 7;
  auto ldk = [&](int jt, int i) -> uint4 { return *(const uint4*)(p.R2 + ((size_t)b * LP + 64 * jt + krow) * 3072 + 2048 + 64 * (4 * hg + i) + kkc * 8); };
  auto ldv = [&](int jt, int i) -> uint4 { return *(const uint4*)(p.R1 + ((size_t)b * 1024 + 512 + 64 * (4 * hg + i) + krow) * LP + 64 * jt + kkc * 8); };
  auto sto = [&](int i, uint4 kk, uint4 vv) { char* sb = smem + i * S_STAGE; *(uint4*)(sb + krow * 144 + kkc * 16) = kk;
    char* vp = sb + S_KSZ + krow * 136 + kkc * 16; *(uint2*)vp = make_uint2(vv.x, vv.y); *(uint2*)(vp + 8) = make_uint2(vv.z, vv.w); };
#define A_LOAD(jt) { k0 = ldk(jt, 0); k1 = ldk(jt, 1); k2 = ldk(jt, 2); k3 = ldk(jt, 3); v0 = ldv(jt, 0); v1 = ldv(jt, 1); v2 = ldv(jt, 2); v3 = ldv(jt, 3); }
#define A_STORE() { sto(0, k0, v0); sto(1, k1, v1); sto(2, k2, v2); sto(3, k3, v3); }
  A_LOAD(jtop); A_STORE();
  __syncthreads();
  bool wdone = false;
  for (int jt = jtop; jt >= 3; --jt) {
    const int cur = w >> 1;
    if (jt > 3) { A_LOAD(jt - 1); }
    if (!wdone) {
      const char* kb_ = smem + cur * S_STAGE + r * 144 + hh * 16;
      f32x16 st[2];
#pragma unroll
      for (int kb = 0; kb < 2; ++kb) {
#pragma unroll
        for (int e = 0; e < 16; ++e) st[kb][e] = 0.f;
#pragma unroll
        for (int s = 0; s < 4; ++s) st[kb] = MFMA32(ld_frag(kb_ + kb * 32 * 144 + s * 32), qf[s], st[kb]);
      }
      const bool edge = (jt == jq) || (jt == 3);
      float running = carry;
#pragma unroll
      for (int kb = 1; kb >= 0; --kb) {
        float t_[16];
#pragma unroll
        for (int g = 3; g >= 0; --g) {
          float sfx = 0.f;
#pragma unroll
          for (int e = 3; e >= 0; --e) { const int i = 4 * g + e; const float z = st[kb][i];
            float ls = -(fmaxf(z, 0.f) + lg2(1.0f + ex2(-fabsf(z))));
            if (edge) { const int kpos = 64 * jt + 32 * kb + 8 * g + 4 * hh + e; if (!(kpos < qpos && kpos >= OFF)) ls = 0.f; }
            sfx += ls; t_[i] = sfx; }
          const auto tt = __builtin_amdgcn_permlane32_swap(__float_as_uint(sfx), __float_as_uint(sfx), false, false);
          const float T0 = __uint_as_float(tt[0]), T1 = __uint_as_float(tt[1]);
          const float base = hh ? running : running + T1;
          running += T1 + T0;
#pragma unroll
          for (int e = 0; e < 4; ++e) { const int i = 4 * g + e; float a = ex2(st[kb][i] + base + t_[i]);
            if (edge) { const int kpos = 64 * jt + 32 * kb + 8 * g + 4 * hh + e; if (!(kpos < qpos && kpos >= OFF)) a = 0.f; }
            st[kb][i] = a; }
        }
      }
      carry = running;
      wdone = !__any(carry > -150.0f);
      const char* vb_ = smem + cur * S_STAGE + S_KSZ + r * 136 + hh * 8;
#pragma unroll
      for (int kb = 0; kb < 2; ++kb)
#pragma unroll
        for (int s2 = 0; s2 < 2; ++s2) { const bf16x8 pf = pack_step(st[kb], s2);
#pragma unroll
          for (int d = 0; d < 2; ++d) O[d] = MFMA32(ld_vfrag(vb_ + d * 32 * 136 + (32 * kb + 16 * s2) * 2), pf, O[d]); }
    }
    {
      int* fl = (int*)(smem + SM_SLOT + 64);
      if (lane == 0) fl[w] = wdone ? 1 : 0;
      __syncthreads();
      const int4 f0 = *(const int4*)fl, f1 = *(const int4*)(fl + 4);
      if (jt == 3 || (f0.x & f0.y & f0.z & f0.w & f1.x & f1.y & f1.z & f1.w) != 0) break;
    }
    A_STORE();
    __syncthreads();
  }
#undef A_LOAD
#undef A_STORE
  if (wact) {
    const bf16_t* G = p.R2 + mq * 3072 + 2560 + 64 * head; bf16_t* Yp = p.R0 + mq * 1024 + 512 + 64 * head;
#pragma unroll
    for (int d = 0; d < 2; ++d)
#pragma unroll
      for (int gp = 0; gp < 2; ++gp) { uint2 ab[2];
#pragma unroll
        for (int k = 0; k < 2; ++k) { const int g = 2 * gp + k; const int dd = 32 * d + 8 * g + 4 * hh; const uint2 gv = *(const uint2*)(G + dd);
          ab[k] = pk4(O[d][4 * g] * silu_f(lo16(gv.x)), O[d][4 * g + 1] * silu_f(hi16(gv.x)), O[d][4 * g + 2] * silu_f(lo16(gv.y)), O[d][4 * g + 3] * silu_f(hi16(gv.y))); }
        store_pair16(Yp, 32 * d + 16 * gp, hh, ab[0], ab[1]); }
  }
}
DI void evattn_phase(const Params& p, int layer, int which, char* smem) {
  const int j = layer >> 1;
  for (;;) { const int id = next_item(p.ctr + layer + 8 * which, smem); if (id >= 17 * 64) break;
    if (id < 17 * 32) { const int T = 16 - id / 32, v = id % 32; const int head = 3 - (v >> 3), b = (v & 7) >> 1, t = 2 * T + 1 - (v & 1);
      if (t >= 1 && (which & 1)) diff_item(p, j, b, head, t, smem); }
    else { const int i2 = id - 17 * 32; const int T = 16 - i2 / 32, u = i2 % 32; const int jq = 4 * T + ((u & 7) >> 1);
      if ((which & 2) && jq >= 3) sb_item(p, u >> 3, u & 1, jq, smem); }
  }
}

#define XB_TMO      128
#define XB_XCNT(j)  (256  + 64 * (j))
#define XB_XSUB(j)  (1280 + 64 * (j))
#define XB_XGEN(j)  (2304 + 64 * (j))
#define XB_TOP      3328
#define XB_TOPGEN   3392
#define XCD_BAR_WORDS 3456
#define XB_SPIN_CAP (1u << 18)
#define LAS __attribute__((address_space(3)))

__device__ __forceinline__ unsigned xb_ld(unsigned* p)              { return __hip_atomic_load(p, __ATOMIC_RELAXED, __HIP_MEMORY_SCOPE_AGENT); }
__device__ __forceinline__ unsigned xb_add(unsigned* p, unsigned v) { return __hip_atomic_fetch_add(p, v, __ATOMIC_RELAXED, __HIP_MEMORY_SCOPE_AGENT); }
__device__ __forceinline__ unsigned xb_xcc_id() { return (unsigned)__builtin_amdgcn_s_getreg((3 << 11) | 20) & 0xFu; }
#define XB_SPIN(cond, bar) do { unsigned _sp = 0; while (cond) { __builtin_amdgcn_s_sleep(1); \
    if ((++_sp & 255u) == 0u) { if (xb_ld(&(bar)[XB_TMO])) break; if (_sp > XB_SPIN_CAP) { atomicAdd(&(bar)[XB_TMO], 1u); break; } } } } while (0)

struct XcdBarrier {
    unsigned* bar; unsigned x;
    volatile LAS unsigned* st;
};

__device__ __forceinline__ XcdBarrier xcd_barrier_post(unsigned* bar, volatile LAS unsigned* st) {
    XcdBarrier b; b.bar = bar; b.x = xb_xcc_id(); b.st = st;
    if (threadIdx.x == 0) (void)xb_add(&bar[XB_XCNT(b.x)], 1u);
    return b;
}
__device__ __forceinline__ void xcd_barrier_complete(unsigned* bar, unsigned x, unsigned& nloc, unsigned& nx) {
    const unsigned G = gridDim.x * gridDim.y * gridDim.z;
    unsigned sum, cnt, mine, sp = 0u;
    for (;;) {
        sum = 0u; cnt = 0u; mine = 0u;
#pragma unroll
        for (unsigned j = 0; j < 16; ++j) { const unsigned c = xb_ld(&bar[XB_XCNT(j)]); sum += c; cnt += (c > 0u) ? 1u : 0u; mine = (j == x) ? c : mine; }
        if (sum == G) break;
        __builtin_amdgcn_s_sleep(1);
        if ((++sp & 255u) == 0u) { if (xb_ld(&bar[XB_TMO])) break; if (sp > XB_SPIN_CAP) { atomicAdd(&bar[XB_TMO], 1u); break; } }
    }
    nloc = mine > 0u ? mine : 1u; nx = cnt > 0u ? cnt : 1u;
}

__device__ __forceinline__ void xcd_barrier(const XcdBarrier& b) {
    asm volatile("s_waitcnt vmcnt(0)" ::: "memory");
    __syncthreads();
    if (threadIdx.x == 0) {
        unsigned* bar = b.bar;
        __builtin_amdgcn_s_waitcnt(0);
        unsigned nloc = b.st[0], nx = b.st[1];
        if (nloc == 0u) { xcd_barrier_complete(bar, b.x, nloc, nx); b.st[0] = nloc; b.st[1] = nx; }
        const unsigned old = xb_add(&bar[XB_XSUB(b.x)], 1u);
        const unsigned gen = old / nloc;
        if (old + 1u == (gen + 1u) * nloc) {
            __builtin_amdgcn_fence(__ATOMIC_RELEASE, "agent");
            asm volatile("s_waitcnt vmcnt(0)" ::: "memory");
            const unsigned og = xb_add(&bar[XB_TOP], 1u);
            const unsigned tg = og / nx;
            if (og + 1u == (tg + 1u) * nx) xb_add(&bar[XB_TOPGEN], 1u);
            else XB_SPIN(xb_ld(&bar[XB_TOPGEN]) == tg, bar);
            __builtin_amdgcn_fence(__ATOMIC_ACQUIRE, "agent");
            xb_add(&bar[XB_XGEN(b.x)], 1u);
            asm volatile("s_waitcnt vmcnt(0)" ::: "memory");
        } else {
            XB_SPIN(xb_ld(&bar[XB_XGEN(b.x)]) == gen, bar);
            __builtin_amdgcn_fence(__ATOMIC_ACQUIRE, "agent");
            asm volatile("s_waitcnt vmcnt(0)" ::: "memory");
        }
    }
    __syncthreads();
}


constexpr int NPHASE = 21;
DI bool phase_noop(int ph) { if (ph == 0) return false; const int layer = (ph - 1) / 5, s = (ph - 1) % 5; return s == 4 || (s == 1 && !(layer & 1)); }
DI void run_phase(const Params& p, int ph, int which, char* smem) {
  if (ph == 0) {
    const int tid = opaque_tid();
    conv_all(p, (float*)smem, tid);
    prep_elem(p, (size_t)blockIdx.x * NTHR + tid, (size_t)gridDim.x * NTHR);
    return;
  }
  const int layer = (ph - 1) / 5, s = (ph - 1) % 5, j = layer >> 1; const bool odd = layer & 1;
  if (s == 0) gemm_phase(p, odd ? 1 : 0, j, layer, smem);
  else if (s == 1) { if (odd) gemm_phase(p, 2, j, layer, smem); }
  else if (s == 2) { if (odd) mla_phase(p, layer, smem); else evattn_phase(p, layer, which, smem); }
  else if (s == 3) gemm_phase(p, 3, j, layer, smem);
}
#ifndef REPWHICH
#define REPWHICH 3
#endif
#ifndef REPMASK
#define REPMASK 0
#endif
__global__ void __launch_bounds__(NTHR) k_mega(Params p, int ph0, int ph1, int which) {
  __shared__ __attribute__((aligned(1024))) char smem[SMEM_BYTES];
  uint4& xb_words = *(uint4*)(smem + SM_SLOT + 256);
  const bool mega = ph1 - ph0 > 1;
  if (threadIdx.x == 0) {
    unsigned slot = 0u;
    if (mega) slot = __hip_atomic_fetch_add(&p.bar[xb_xcc_id()], 1u, __ATOMIC_RELAXED, __HIP_MEMORY_SCOPE_AGENT);
    xb_words = make_uint4(0u, 0u, blockIdx.x, slot);
  }
  __syncthreads();
  if (mega) (void)xcd_barrier_post(p.bar, (volatile LAS unsigned*)&xb_words);
#define XBAR() { XcdBarrier xb_; xb_.bar = p.bar; xb_.x = xb_xcc_id(); xb_.st = (volatile LAS unsigned*)&xb_words; xcd_barrier(xb_); }
  int nsync = 0;
  if (ph0 == 0) {
    run_phase(p, 0, which, smem);
    if (((REPMASK >> 11) & 1)) { cg::this_grid().sync(); run_phase(p, 0, which, smem); }
    if (ph1 > 1) { if (which < 0) cg::this_grid().sync();
                   XBAR(); }
    ph0 = 1;
  }
  if (mega) {
    if (threadIdx.x == 0) {
      const unsigned slot = xb_words.w, x = xb_xcc_id(); unsigned rank = 0u;
      for (unsigned k = 0; k < 16; ++k) { const unsigned cnt = __hip_atomic_load(&p.bar[k], __ATOMIC_RELAXED, __HIP_MEMORY_SCOPE_AGENT); rank += cnt < slot ? cnt : slot; if (k < x && cnt > slot) ++rank; }
      xb_words.z = rank;
    }
    __syncthreads();
  }
  for (int ph = ph0; ph < ph1; ++ph) {
    if (phase_noop(ph)) continue;
    if (nsync > 0) XBAR();
    ++nsync;
    run_phase(p, ph, which, smem);
    if (REPMASK && ph > 0) {
      const int layer = (ph - 1) / 5, s = (ph - 1) % 5;
      if ((REPMASK >> (s + 5 * (layer & 1))) & 1) { XBAR(); p.ctr += 32; run_phase(p, ph, REPWHICH, smem); p.ctr -= 32; }
      if (((REPMASK >> 10) & 1) && ph == 1) { for (int i = 0; i < 20; ++i) XBAR(); }
    }
  }
}

extern "C" void kernel_launch(void* const* d_in, const int* in_sizes, int n_in, void* d_out, int out_size, void* d_ws, size_t ws_size, hipStream_t stream) {
  Params p{};
  p.x = (const float*)d_in[0]; p.meta = (const float*)d_in[1]; p.ln_g = (const float*)d_in[2]; p.ln_b = (const float*)d_in[3];
  p.ev_w_in = (const float*)d_in[4]; p.ev_w_out = (const float*)d_in[5]; p.lq1 = (const float*)d_in[6]; p.lk1 = (const float*)d_in[7];
  p.lq2 = (const float*)d_in[8]; p.lk2 = (const float*)d_in[9]; p.subln = (const float*)d_in[10]; p.od_w_in = (const float*)d_in[11];
  p.od_qn = (const float*)d_in[12]; p.od_w_uq = (const float*)d_in[13]; p.od_kvn = (const float*)d_in[14]; p.od_w_ukv = (const float*)d_in[15];
  p.od_w_out = (const float*)d_in[16];
  p.out = (float*)d_out;
  char* w = (char*)d_ws; size_t o = 0;
  auto take = [&](size_t bytes) { char* r = w + o; o += (bytes + 255) & ~(size_t)255; return r; };
  p.W_evin = (bf16_t*)take((size_t)2 * 4096 * 1024 * 2); p.W_evout = (bf16_t*)take((size_t)2 * 1024 * 1024 * 2);
  p.W_odin = (bf16_t*)take((size_t)2 * 2048 * 1024 * 2); p.W_oduq = (bf16_t*)take((size_t)2 * 1536 * 512 * 2);
  p.W_odukv = (bf16_t*)take((size_t)2 * 2048 * 256 * 2); p.W_odout = (bf16_t*)take((size_t)2 * 1024 * 1024 * 2);
  p.R0 = (bf16_t*)take((size_t)MP * 1024 * 2); p.R1 = (bf16_t*)take((size_t)MP * 1024 * 2);
  p.R2 = (bf16_t*)take((size_t)MP * 3072 * 2); p.R3 = (bf16_t*)take((size_t)MP * 1024 * 2);
  p.hmeta = (float*)take((size_t)NB * 64 * DM * 4); p.rope = (float*)take((size_t)LP * 64 * 4);
  p.lam = (float*)take(256); p.ctr = (unsigned*)take(512); p.rowss = (float*)take((size_t)MP * 24 * 4); p.rsarr = (float*)take((size_t)MP * 2 * 4); p.bar = (unsigned*)take((size_t)(XCD_BAR_WORDS + 4 * 68 * 16) * 4); p.pcnt = p.bar + XCD_BAR_WORDS; p.xch = (float*)take((size_t)68 * 1024 * 8);
  if (o > ws_size) { fprintf(stderr, "workspace too small: need %zu have %zu\n", o, ws_size); return; }

#ifndef MODE_MEGA
#define MODE_MEGA 1
#endif
#ifndef FASTMASK
#define FASTMASK 127
#endif
  hipMemsetAsync(p.bar, 0, (size_t)(XCD_BAR_WORDS + 4 * 68 * 16) * 4, stream);
#if MODE_MEGA
  static int grid_blocks = 0;
  if (!grid_blocks) {
    int dev = 0, cus = 0, per_cu = 0;
    hipGetDevice(&dev);
    hipDeviceGetAttribute(&cus, hipDeviceAttributeMultiprocessorCount, dev);
    hipOccupancyMaxActiveBlocksPerMultiprocessor(&per_cu, k_mega, NTHR, 0);
    if (per_cu > 1) per_cu = 1;
    grid_blocks = cus * per_cu;
  }
  int ph0 = 0, ph1 = NPHASE, which = 3;
  void* args[] = {&p, &ph0, &ph1, &which};
  hipError_t e = hipLaunchCooperativeKernel((void*)k_mega, dim3(grid_blocks), dim3(NTHR), args, 0, stream);
  if (e != hipSuccess) fprintf(stderr, "cooperative launch failed: %s (grid %d)\n", hipGetErrorString(e), grid_blocks);
#else
  const int G = 256;
#ifndef REPWH
#define REPWH 0
#endif
#ifndef HOSTREP
#define HOSTREP 0
#endif
#define LAUNCH_PH(ph, wh) { k_mega<<<G, NTHR, 0, stream>>>(p, ph, (ph) + 1, wh); \
    if ((HOSTREP >> ((((ph) - 1) % 5) + 5 * ((((ph) - 1) / 5) & 1))) & 1) { hipMemsetAsync(p.ctr, 0, 512, stream); k_mega<<<G, NTHR, 0, stream>>>(p, ph, (ph) + 1, REPWH ? REPWH : (wh)); } }
  k_mega<<<G, NTHR, 0, stream>>>(p, 0, 1, 3);
  for (int layer = 0; layer < 4; ++layer) {
    const int j = layer >> 1; const int pb = 1 + layer * 5;
    if ((layer & 1) == 0) {
      if (FASTMASK & 1) LAUNCH_PH(pb, 3) else nv_gemm<0><<<(unsigned)(((size_t)NB * NR * 4096 + 255) / 256), 256, 0, stream>>>(p, j);
      const int which = ((FASTMASK & 2) ? 1 : 0) | ((FASTMASK & 4) ? 2 : 0);
      if (which) LAUNCH_PH(pb + 2, which)
      if (!(FASTMASK & 2)) nv_attn<0><<<NB * NR * 4 / 2, 128, 0, stream>>>(p, j);
      if (!(FASTMASK & 4)) nv_attn<1><<<NB * NR * 8 / 2, 128, 0, stream>>>(p, j);
      if (FASTMASK & 8) { k_mega<<<G, NTHR, 0, stream>>>(p, pb + 3, pb + 4, 3); k_mega<<<G, NTHR, 0, stream>>>(p, pb + 4, pb + 5, 3); }
      else nv_out_ln<<<NB * NR, 256, 0, stream>>>(p, layer, p.R0, p.W_evout + (size_t)j * 1024 * 1024);
    } else {
      if (FASTMASK & 16) LAUNCH_PH(pb, 3) else nv_gemm<1><<<(unsigned)(((size_t)NB * NR * 1856 + 255) / 256), 256, 0, stream>>>(p, j);
      if (FASTMASK & 32) LAUNCH_PH(pb + 1, 3)
      else { nv_gemm<2><<<(unsigned)(((size_t)NB * NR * 1536 + 255) / 256), 256, 0, stream>>>(p, j); nv_gemm<3><<<(unsigned)(((size_t)NB * NR * 2048 + 255) / 256), 256, 0, stream>>>(p, j); }
      if (FASTMASK & 64) LAUNCH_PH(pb + 2, 3) else nv_attn<2><<<NB * NR * 8 / 2, 128, 0, stream>>>(p, j);
      if (FASTMASK & 8) { k_mega<<<G, NTHR, 0, stream>>>(p, pb + 3, pb + 4, 3); k_mega<<<G, NTHR, 0, stream>>>(p, pb + 4, pb + 5, 3); }
      else nv_out_ln<<<NB * NR, 256, 0, stream>>>(p, layer, p.R3, p.W_odout + (size_t)j * 1024 * 1024);
    }
  }
#endif
}
```
